# Optimizing an MI355X kernel written in HIP

```python
import jax
import jax.numpy as jnp
from jax import lax
import numpy as np

D_MODEL = 4096
BATCH = 4
SEQ = 2048
DEPTH = 2

D_FF = 4 * D_MODEL
NORM_EPS = 1e-6
LRU_WIDTH = D_MODEL // 2
LRU_HEADS = 8
LRU_BLOCK = LRU_WIDTH // LRU_HEADS
CONV_WIDTH = 4
LRU_C = 8.0
RWKV_WIDTH = D_MODEL // 2
RWKV_HEAD = 64
RWKV_HEADS = RWKV_WIDTH // RWKV_HEAD
DECAY_LORA = 96
AAA_LORA = 96
GATE_LORA = 256
RWKV_COLS = 3 * RWKV_WIDTH + DECAY_LORA + AAA_LORA + GATE_LORA
GN_EPS = 64e-5
HY_IN = 2 * LRU_WIDTH + RWKV_COLS
ML_HEADS = 8
ML_QK = D_MODEL // 2
ML_V = D_MODEL
ML_DQK = ML_QK // ML_HEADS
ML_DV = ML_V // ML_HEADS
ML_CHUNK = 64
ML_IN = 2 * ML_QK + 2 * ML_V + 2 * ML_HEADS
N_EVEN = (DEPTH + 1) // 2
N_ODD = DEPTH // 2

kernel_name = "hybrid_rglru_rwkv7_mlstm_block"

F32 = jnp.float32


def rmsnorm(x, g, eps=NORM_EPS):
    xf = x.astype(F32)
    y = xf * lax.rsqrt(jnp.mean(xf * xf, axis=-1, keepdims=True) + eps)
    return (y * g.astype(F32)).astype(x.dtype)


def shift_right(z):
    return jnp.pad(z, ((0, 0), (1, 0), (0, 0)))[:, :-1]


def causal_depthwise_conv(u, w, b):
    seq = u.shape[1]
    up = jnp.pad(u, ((0, 0), (CONV_WIDTH - 1, 0), (0, 0)))
    out = b
    for j in range(CONV_WIDTH):
        out = out + w[j] * up[:, j:j + seq]
    return out


def linear_recurrence_combine(c1, c2):
    a1, b1 = c1
    a2, b2 = c2
    return a1 * a2, a2 * b1 + b2


def rglru_branch(z, conv_w, conv_b, w_a, b_a, w_x, b_x, lam):
    bsz, seq, _ = z.shape
    u = z[..., :LRU_WIDTH].astype(F32)
    gate = jax.nn.gelu(z[..., LRU_WIDTH:].astype(F32))
    u = causal_depthwise_conv(u, conv_w.astype(F32), conv_b.astype(F32))
    ub = u.reshape(bsz, seq, LRU_HEADS, LRU_BLOCK)
    r = jax.nn.sigmoid(jnp.einsum("bshi,hij->bshj", ub, w_a.astype(F32)).reshape(bsz, seq, LRU_WIDTH) + b_a.astype(F32))
    i = jax.nn.sigmoid(jnp.einsum("bshi,hij->bshj", ub, w_x.astype(F32)).reshape(bsz, seq, LRU_WIDTH) + b_x.astype(F32))
    log_a = -LRU_C * r * jax.nn.softplus(-lam.astype(F32))
    a = jnp.exp(log_a)
    b = jnp.sqrt(-jnp.expm1(2.0 * log_a)) * (i * u)
    _, hseq = lax.associative_scan(linear_recurrence_combine, (a, b), axis=1)
    return hseq * gate


def rwkv7_branch(z, mu, w0, w2, a0, a2, g2, k_k, k_a, r_k, ln_w, ln_b):
    bsz, seq, _ = z.shape
    w0, w2, a0, a2, g2, k_k, k_a, r_k, ln_w, ln_b = (
        p.astype(F32) for p in (w0, w2, a0, a2, g2, k_k, k_a, r_k, ln_w, ln_b))
    z = z.astype(F32)
    z = z + (shift_right(z) - z) * mu.astype(F32)
    W = RWKV_WIDTH
    r = z[..., :W]
    k = z[..., W:2 * W]
    v = z[..., 2 * W:3 * W]
    o = 3 * W
    wl = z[..., o:o + DECAY_LORA]
    o += DECAY_LORA
    al = z[..., o:o + AAA_LORA]
    o += AAA_LORA
    gl = z[..., o:o + GATE_LORA]
    w = -jax.nn.softplus(-(w0 + jnp.tanh(wl) @ w2)) - 0.5
    decay = jnp.exp(-jnp.exp(w))
    a = jax.nn.sigmoid(a0 + al @ a2)
    g = jax.nn.sigmoid(gl) @ g2

    def hd(t):
        return t.reshape(bsz, seq, RWKV_HEADS, RWKV_HEAD)

    kk = hd(k * k_k)
    kk = kk / jnp.maximum(jnp.linalg.norm(kk, axis=-1, keepdims=True), 1e-12)
    k = k * (1.0 + (a - 1.0) * k_a)
    r, k, v, decay, a = (hd(t) for t in (r, k, v, decay, a))

    def tm(t):
        return jnp.swapaxes(t, 0, 1)

    def step(state, inp):
        r_t, w_t, k_t, v_t, kk_t, kka_t = inp
        sa = jnp.einsum("bhvk,bhk->bhv", state, kk_t)
        state = (state * w_t[:, :, None, :]
                 - sa[..., :, None] * kka_t[..., None, :]
                 + v_t[..., :, None] * k_t[..., None, :])
        return state, jnp.einsum("bhvk,bhk->bhv", state, r_t)

    s0 = jnp.zeros((bsz, RWKV_HEADS, RWKV_HEAD, RWKV_HEAD), F32)
    _, y = lax.scan(step, s0, (tm(r), tm(decay), tm(k), tm(v), tm(kk), tm(kk * a)))
    y = tm(y)
    mean = jnp.mean(y, axis=-1, keepdims=True)
    var = jnp.mean(jnp.square(y - mean), axis=-1, keepdims=True)
    y = (y - mean) * lax.rsqrt(var + GN_EPS) * ln_w.reshape(RWKV_HEADS, RWKV_HEAD) + ln_b.reshape(RWKV_HEADS, RWKV_HEAD)
    bonus = jnp.sum(r * k * r_k.reshape(RWKV_HEADS, RWKV_HEAD), axis=-1, keepdims=True) * v
    return (y + bonus).reshape(bsz, seq, W) * g


def mlstm_chunk_step(carry, inp):
    c_mat, n_vec, m_st = carry
    q, k, v, li, lf = inp
    L = q.shape[2]
    b = jnp.cumsum(lf, axis=-1)
    causal = jnp.tril(jnp.ones((L, L), dtype=bool))
    log_d = jnp.where(causal, b[..., :, None] - b[..., None, :] + li[..., None, :], -jnp.inf)
    log_inter = b + m_st[..., None]
    m_t = jnp.maximum(jnp.max(log_d, axis=-1), log_inter)
    p = jnp.einsum("bhld,bhsd->bhls", q, k) * jnp.exp(log_d - m_t[..., None])
    inter = jnp.exp(log_inter - m_t)
    num = jnp.einsum("bhls,bhsv->bhlv", p, v) + inter[..., None] * jnp.einsum("bhld,bhdv->bhlv", q, c_mat)
    den = jnp.sum(p, axis=-1) + inter * jnp.einsum("bhld,bhd->bhl", q, n_vec)
    h = num / jnp.maximum(jnp.abs(den), jnp.exp(-m_t))[..., None]
    b_last = b[..., -1]
    log_g = b_last[..., None] - b + li
    m_new = jnp.maximum(b_last + m_st, jnp.max(log_g, axis=-1))
    carry_decay = jnp.exp(b_last + m_st - m_new)
    wk = k * jnp.exp(log_g - m_new[..., None])[..., None]
    c_new = carry_decay[..., None, None] * c_mat + jnp.einsum("bhsd,bhsv->bhdv", wk, v)
    n_new = carry_decay[..., None] * n_vec + jnp.sum(wk, axis=2)
    return (c_new, n_new, m_new), h


def mlstm_mixer(hn, w_in, b_i, b_f, norm_w, w_out):
    bsz, seq, _ = hn.shape
    nc = seq // ML_CHUNK
    z = (hn @ w_in).astype(F32)
    o = 0
    zq = z[..., o:o + ML_QK]
    o += ML_QK
    zk = z[..., o:o + ML_QK]
    o += ML_QK
    zv = z[..., o:o + ML_V]
    o += ML_V
    zo = z[..., o:o + ML_V]
    o += ML_V
    zi = z[..., o:o + ML_HEADS]
    o += ML_HEADS
    zf = z[..., o:o + ML_HEADS]

    def chunk_heads(t, d):
        return t.reshape(bsz, nc, ML_CHUNK, ML_HEADS, d).transpose(1, 0, 3, 2, 4)

    def chunk_gates(t):
        return t.reshape(bsz, nc, ML_CHUNK, ML_HEADS).transpose(1, 0, 3, 2)

    q = chunk_heads(zq * (ML_DQK ** -0.5), ML_DQK)
    k = chunk_heads(zk, ML_DQK)
    v = chunk_heads(zv, ML_DV)
    li = chunk_gates(zi + b_i.astype(F32))
    lf = chunk_gates(jax.nn.log_sigmoid(zf + b_f.astype(F32)))
    init = (jnp.zeros((bsz, ML_HEADS, ML_DQK, ML_DV), F32),
            jnp.zeros((bsz, ML_HEADS, ML_DQK), F32),
            jnp.zeros((bsz, ML_HEADS), F32))
    _, hs = lax.scan(mlstm_chunk_step, init, (q, k, v, li, lf))
    hs = hs.transpose(1, 0, 3, 2, 4).reshape(bsz, seq, ML_HEADS, ML_DV)
    hs = hs * lax.rsqrt(jnp.mean(hs * hs, axis=-1, keepdims=True) + NORM_EPS)
    hs = hs.reshape(bsz, seq, ML_V) * norm_w.astype(F32) * jax.nn.sigmoid(zo)
    return hs.astype(hn.dtype) @ w_out


def sq_relu_mlp(h, w_up, w_down):
    u = jax.nn.relu(h @ w_up)
    return (u * u) @ w_down


def setup_inputs(seed: int = 0) -> dict:
    key = jax.random.key(seed)
    ks = iter(jax.random.split(key, 40))

    def nrm(shape, scale):
        return jax.random.normal(next(ks), shape, F32) * scale

    def unif(shape, lo, hi):
        return jax.random.uniform(next(ks), shape, F32, lo, hi)

    a_base = unif((N_EVEN, LRU_WIDTH), 0.9, 0.999)
    return {
        "x": nrm((BATCH, SEQ, D_MODEL), 1.0),
        "norm_mix": 1.0 + nrm((DEPTH, D_MODEL), 0.02),
        "norm_mlp": 1.0 + nrm((DEPTH, D_MODEL), 0.02),
        "norm_final": 1.0 + nrm((D_MODEL,), 0.02),
        "mlp_up": nrm((DEPTH, D_MODEL, D_FF), D_MODEL ** -0.5),
        "mlp_down": nrm((DEPTH, D_FF, D_MODEL), D_FF ** -0.5),
        "hy_in": nrm((N_EVEN, D_MODEL, HY_IN), D_MODEL ** -0.5),
        "lru_conv_w": nrm((N_EVEN, CONV_WIDTH, LRU_WIDTH), CONV_WIDTH ** -0.5),
        "lru_conv_b": nrm((N_EVEN, LRU_WIDTH), 0.02),
        "lru_wa": nrm((N_EVEN, LRU_HEADS, LRU_BLOCK, LRU_BLOCK), LRU_BLOCK ** -0.5),
        "lru_ba": nrm((N_EVEN, LRU_WIDTH), 0.1),
        "lru_wx": nrm((N_EVEN, LRU_HEADS, LRU_BLOCK, LRU_BLOCK), LRU_BLOCK ** -0.5),
        "lru_bx": nrm((N_EVEN, LRU_WIDTH), 0.1),
        "lru_lam": jnp.log(a_base) - jnp.log1p(-a_base),
        "rwkv_mu": unif((N_EVEN, RWKV_COLS), 0.0, 1.0),
        "rwkv_w0": unif((N_EVEN, RWKV_WIDTH), -6.0, -1.0),
        "rwkv_w2": nrm((N_EVEN, DECAY_LORA, RWKV_WIDTH), 0.5 * DECAY_LORA ** -0.5),
        "rwkv_a0": nrm((N_EVEN, RWKV_WIDTH), 0.1),
        "rwkv_a2": nrm((N_EVEN, AAA_LORA, RWKV_WIDTH), 0.5 * AAA_LORA ** -0.5),
        "rwkv_g2": nrm((N_EVEN, GATE_LORA, RWKV_WIDTH), GATE_LORA ** -0.5),
        "rwkv_kk": 0.85 + nrm((N_EVEN, RWKV_WIDTH), 0.05),
        "rwkv_ka": 1.0 + nrm((N_EVEN, RWKV_WIDTH), 0.05),
        "rwkv_rk": nrm((N_EVEN, RWKV_WIDTH), 0.1),
        "rwkv_ln_w": 1.0 + nrm((N_EVEN, RWKV_WIDTH), 0.02),
        "rwkv_ln_b": nrm((N_EVEN, RWKV_WIDTH), 0.02),
        "hy_out": nrm((N_EVEN, LRU_WIDTH + RWKV_WIDTH, D_MODEL), (LRU_WIDTH + RWKV_WIDTH) ** -0.5),
        "ml_in": nrm((N_ODD, D_MODEL, ML_IN), D_MODEL ** -0.5),
        "ml_bi": -2.0 + nrm((N_ODD, ML_HEADS), 0.1),
        "ml_bf": unif((N_ODD, ML_HEADS), 3.0, 6.0),
        "ml_norm": 1.0 + nrm((N_ODD, ML_V), 0.02),
        "ml_out": nrm((N_ODD, ML_V, D_MODEL), ML_V ** -0.5),
    }


def reference(x, norm_mix, norm_mlp, norm_final, mlp_up, mlp_down, hy_in, lru_conv_w, lru_conv_b,
              lru_wa, lru_ba, lru_wx, lru_bx, lru_lam, rwkv_mu, rwkv_w0, rwkv_w2, rwkv_a0, rwkv_a2,
              rwkv_g2, rwkv_kk, rwkv_ka, rwkv_rk, rwkv_ln_w, rwkv_ln_b, hy_out, ml_in, ml_bi, ml_bf,
              ml_norm, ml_out):
    for layer in range(DEPTH):
        h = rmsnorm(x, norm_mix[layer])
        if layer % 2 == 0:
            e = layer // 2
            z = h @ hy_in[e]
            ya = rglru_branch(z[..., :2 * LRU_WIDTH], lru_conv_w[e], lru_conv_b[e], lru_wa[e], lru_ba[e],
                              lru_wx[e], lru_bx[e], lru_lam[e])
            yb = rwkv7_branch(z[..., 2 * LRU_WIDTH:], rwkv_mu[e], rwkv_w0[e], rwkv_w2[e], rwkv_a0[e],
                              rwkv_a2[e], rwkv_g2[e], rwkv_kk[e], rwkv_ka[e], rwkv_rk[e],
                              rwkv_ln_w[e], rwkv_ln_b[e])
            mix = jnp.concatenate([ya, yb], axis=-1).astype(x.dtype) @ hy_out[e]
        else:
            o = layer // 2
            mix = mlstm_mixer(h, ml_in[o], ml_bi[o], ml_bf[o], ml_norm[o], ml_out[o])
        x = x + mix
        x = x + sq_relu_mlp(rmsnorm(x, norm_mlp[layer]), mlp_up[layer], mlp_down[layer])
    return rmsnorm(x, norm_final)
```

```cpp
#include <hip/hip_runtime.h>
#include <cstdio>
#include <cstdint>

#ifndef MK_N_LAUNCHES
#define MK_N_LAUNCHES 15
#endif

namespace pg8 {
#define PG8_LAS __attribute__((address_space(3)))
typedef unsigned short bf16_t;
typedef short bf16x8 __attribute__((ext_vector_type(8)));
typedef float f32x4 __attribute__((ext_vector_type(4)));
typedef unsigned u32x4 __attribute__((ext_vector_type(4)));
typedef unsigned u32x2 __attribute__((ext_vector_type(2)));
constexpr int BM = 256, BK = 64, HALF = 128, HTB = HALF * BK * 2  , STAGE_BYTES = 8 * HTB, NXCD = 8, WGM = 8;

__host__ __device__ __forceinline__ int lds_byte(int r, int c) { const int st = (r >> 4) * 2 + (c >> 5), rr = r & 15, cc = c & 31, ob = rr * 64 + cc * 2; return st * 1024 + (ob ^ (((ob >> 9) & 1) << 5)); }
__host__ __device__ __forceinline__ void stage_rc(int b, int& R, int& C) { const int st = b / 1024, sb = b % 1024, swz = sb ^ (((sb >> 9) & 1) << 5); R = (st >> 1) * 16 + swz / 64; C = (st & 1) * 32 + (swz % 64) / 2; }
__host__ __device__ __forceinline__ int perm32(int rho) { const int n = rho >> 4, i = rho & 15; return 8 * (i >> 2) + 4 * n + (i & 3); }

struct Unit { int pm, pn, ka, kb, ui; };
struct Gemm { const bf16_t* A; const bf16_t* Bt; int lda, ldb, K; };

struct StaticOrder {
    int nM, nN, nwg, G, c;
    __host__ __device__ void init(int M, int N, int G_, int c_) { nM = M / BM; nN = N / BM; nwg = nM * nN; G = G_; c = c_; }
    __host__ __device__ bool next(int i, Unit& u) const {
        const long L = (long)i * G + c; if (L >= nwg) return false;
        int wgid = (int)L; { const int q = nwg / NXCD, r = nwg % NXCD, xcd = wgid % NXCD, off = wgid / NXCD; wgid = (xcd < r ? xcd * (q + 1) : r * (q + 1) + (xcd - r) * q) + off; }
        const int nig = WGM * nN, gid = wgid / nig, fm = gid * WGM, gsz = (nM - fm) < WGM ? (nM - fm) : WGM;
        u.pm = fm + ((wgid % nig) % gsz); u.pn = (wgid % nig) / gsz; u.ka = 0; u.kb = 0; u.ui = i; return true;
    }
    __device__ __forceinline__ void a_ready(const Unit&) const {}
    __device__ __forceinline__ void done(const Unit&) const {}
};
struct HeadOrder {
    int nM, nH, nwg, G, c, K;
    __host__ __device__ void init(int M, int nH_, int K_, int G_, int c_) { nM = M / BM; nH = nH_; nwg = nM * nH; G = G_; c = c_; K = K_; }
    __host__ __device__ bool next(int i, Unit& u) const {
        const long L = (long)i * G + c; if (L >= nwg) return false;
        u.pm = (int)(L % nM); u.pn = (int)(L / nM); u.ka = u.pn * K; u.kb = 0; u.ui = i; return true;
    }
    __device__ __forceinline__ void a_ready(const Unit&) const {}
    __device__ __forceinline__ void done(const Unit&) const {}
};

__device__ __forceinline__ unsigned cvt_pk_bf16(float lo, float hi) { unsigned r; asm volatile("v_cvt_pk_bf16_f32 %0, %1, %2" : "=v"(r) : "v"(lo), "v"(hi)); return r; }

template <int ACT> struct EpiScale {
    static constexpr bool PERM = true, AFTER_DRAIN = false;
    bf16_t* O; int ldc; const PG8_LAS float* rs;
    __device__ __forceinline__ void operator()(const f32x4 (&acc)[2][2][4][2], const Unit& u, int wr, int wc, int fr, int fq) const {
        const int row0 = u.pm * BM + wr * 64 + fr, col0 = u.pn * BM + wc * 32 + 8 * fq;
        const PG8_LAS float* rt = rs + u.ui * 256 + wr * 64 + fr;
#pragma unroll
        for (int ai = 0; ai < 2; ++ai)
#pragma unroll
            for (int m = 0; m < 4; ++m) { bf16_t* rowp = O + (size_t)(row0 + ai * HALF + m * 16) * ldc + col0; const float s = rt[ai * HALF + m * 16];
#pragma unroll
                for (int bj = 0; bj < 2; ++bj) { f32x4 v0 = acc[ai][bj][m][0] * s, v1 = acc[ai][bj][m][1] * s;
                    if (ACT == 1) {
#pragma unroll
                        for (int e = 0; e < 4; ++e) { const float a = fmaxf(v0[e], 0.f), b = fmaxf(v1[e], 0.f); v0[e] = a * a; v1[e] = b * b; } }
                    u32x4 w; w.x = cvt_pk_bf16(v0[0], v0[1]); w.y = cvt_pk_bf16(v0[2], v0[3]); w.z = cvt_pk_bf16(v1[0], v1[1]); w.w = cvt_pk_bf16(v1[2], v1[3]);
                    *(u32x4*)(rowp + bj * HALF) = w; } }
    }
};
struct EpiResid {
    static constexpr bool PERM = false, AFTER_DRAIN = false;
    const float* xin; float* xout; bf16_t* xb; float* ssq; int ldc;
    __device__ __forceinline__ void operator()(const f32x4 (&acc)[2][2][4][2], const Unit& u, int wr, int wc, int fr, int fq) const {
        const int col0 = u.pn * BM + wc * 32 + 4 * fq;
#pragma unroll
        for (int ai = 0; ai < 2; ++ai)
#pragma unroll
            for (int m = 0; m < 4; ++m) { const int row = u.pm * BM + ai * HALF + wr * 64 + m * 16 + fr; float q = 0.f;
#pragma unroll
                for (int bj = 0; bj < 2; ++bj)
#pragma unroll
                    for (int n = 0; n < 2; ++n) { const size_t o = (size_t)row * ldc + col0 + bj * HALF + 16 * n;
                        const f32x4 v = acc[ai][bj][m][n] + *(const f32x4*)(xin + o);
                        *(f32x4*)(xout + o) = v;
                        u32x2 w; w.x = cvt_pk_bf16(v[0], v[1]); w.y = cvt_pk_bf16(v[2], v[3]); *(u32x2*)(xb + o) = w;
                        q += (v[0] * v[0] + v[1] * v[1]) + (v[2] * v[2] + v[3] * v[3]); }
                q += __shfl_xor(q, 16); q += __shfl_xor(q, 32);
                if (fq == 0) ssq[(size_t)row * 64 + u.pn * 4 + wc] = q; }
    }
};
struct EpiLora {
    static constexpr bool PERM = false, AFTER_DRAIN = false;
    float* O; int ldc; const float* bias; int kind;
    __device__ __forceinline__ void operator()(const f32x4 (&acc)[2][2][4][2], const Unit& u, int wr, int wc, int fr, int fq) const {
        const int col0 = u.pn * BM + wc * 32 + 4 * fq;
#pragma unroll
        for (int bj = 0; bj < 2; ++bj)
#pragma unroll
            for (int n = 0; n < 2; ++n) { const int c = col0 + bj * HALF + 16 * n; f32x4 bv = (f32x4){0.f, 0.f, 0.f, 0.f}; if (kind != 2) bv = *(const f32x4*)(bias + c);
#pragma unroll
                for (int ai = 0; ai < 2; ++ai)
#pragma unroll
                    for (int m = 0; m < 4; ++m) { const int row = u.pm * BM + ai * HALF + wr * 64 + m * 16 + fr; f32x4 v = acc[ai][bj][m][n] + bv;
                        if (kind == 0) {
#pragma unroll
                            for (int e = 0; e < 4; ++e) { const float x = -v[e]; const float sp = fmaxf(x, 0.f) + log1pf(expf(-fabsf(x))); v[e] = expf(-expf(-sp - 0.5f)); } }
                        else if (kind == 1) {
#pragma unroll
                            for (int e = 0; e < 4; ++e) v[e] = 1.f / (1.f + expf(-v[e])); }
                        *(f32x4*)(O + (size_t)row * ldc + c) = v; } }
    }
};


template <class Epi, class Sched, bool ALIGN_EPI = false, bool SP2 = false>
__device__ __forceinline__ void gemm_phase(PG8_LAS unsigned char* lds, const Gemm g, const Sched& S, const Epi& E) {
    const int tid = threadIdx.x, wid = __builtin_amdgcn_readfirstlane(tid >> 6), lane = tid & 63, wr = wid >> 2, wc = wid & 3, fr = lane & 15, fq = lane >> 4;
    const int K = g.K, nt = K / BK, lda = g.lda, ldb = g.ldb;
    unsigned voffA[2], voffB[2];
#pragma unroll
    for (int i = 0; i < 2; ++i) { int R, C; stage_rc(tid * 16 + i * 8192, R, C); const int Rb = Epi::PERM ? ((R & ~31) + perm32(R & 31)) : R;
        voffA[i] = (unsigned)(R * lda + C) * 2u; voffB[i] = (unsigned)(Rb * ldb + C) * 2u; }
    const size_t kstep = (size_t)(BK * 2);
    const size_t hstepA = (size_t)HALF * lda * 2, hstepB = (size_t)HALF * ldb * 2;
    const size_t tstepA = 2 * hstepA, tstepB = 2 * hstepB;
    const unsigned ldsw = (unsigned)wid * 1024u;
    const int aoff = lds_byte(wr * 64 + fr, fq * 8), boff = lds_byte(wc * 32 + fr, fq * 8);
#define PG8_SA(b, h) (((b) * 2 + (h)) * HTB)
#define PG8_SB(b, h) ((4 + (b) * 2 + (h)) * HTB)
#define PG8_STAGE(bufoff, gbase, voff) do { _Pragma("unroll") for (int _i = 0; _i < 2; ++_i) \
        __builtin_amdgcn_global_load_lds((const unsigned*)((const char*)(gbase) + (voff)[_i]), (PG8_LAS unsigned*)(lds + (bufoff) + ldsw + _i * 8192), 16, 0, 0); } while (0)
#define PG8_LDA(dst, b, h) do { _Pragma("unroll") for (int m = 0; m < 4; ++m) _Pragma("unroll") for (int k = 0; k < 2; ++k) dst[m][k] = *(const PG8_LAS bf16x8*)(lds + PG8_SA(b, h) + aoff + m * 2048 + k * 1024); } while (0)
#define PG8_LDB(dst, b, h) do { _Pragma("unroll") for (int n = 0; n < 2; ++n) _Pragma("unroll") for (int k = 0; k < 2; ++k) dst[n][k] = *(const PG8_LAS bf16x8*)(lds + PG8_SB(b, h) + boff + n * 2048 + k * 1024); } while (0)
#define PG8_MMA(ai, bj, At, Bt) do { __builtin_amdgcn_s_setprio(1); _Pragma("unroll") for (int m = 0; m < 4; ++m) _Pragma("unroll") for (int n = 0; n < 2; ++n) _Pragma("unroll") for (int k = 0; k < 2; ++k) \
        acc[ai][bj][m][n] = __builtin_amdgcn_mfma_f32_16x16x32_bf16(Bt[n][k], At[m][k], acc[ai][bj][m][n], 0, 0, 0); __builtin_amdgcn_s_setprio(0); } while (0)
#define PG8_WAIT_V(n) asm volatile("s_waitcnt vmcnt(" #n ")" ::: "memory")
#define PG8_WAIT_L(n) asm volatile("s_waitcnt lgkmcnt(" #n ")" ::: "memory")
#define PG8_BAR __builtin_amdgcn_s_barrier()
#define PG8_SCHED __builtin_amdgcn_sched_barrier(0)
    Unit cur, nxt; int ui = 0;
    if (!S.next(0, cur)) return;
    f32x4 acc[2][2][4][2];
#pragma unroll
    for (int a = 0; a < 2; ++a)
#pragma unroll
        for (int b = 0; b < 2; ++b)
#pragma unroll
            for (int m = 0; m < 4; ++m)
#pragma unroll
                for (int n = 0; n < 2; ++n) acc[a][b][m][n] = (f32x4){0.f, 0.f, 0.f, 0.f};
    bf16x8 At[4][2], B0[2][2], B1[2][2];
    const char* cA = (const char*)g.A + (size_t)cur.pm * tstepA + (size_t)cur.ka * 2; const char* cB = (const char*)g.Bt + (size_t)cur.pn * tstepB + (size_t)cur.kb * 2;
    S.a_ready(cur);
    if constexpr (SP2) {
        PG8_STAGE(PG8_SB(0, 0), cB, voffB); PG8_STAGE(PG8_SB(0, 1), cB + hstepB, voffB); PG8_STAGE(PG8_SA(0, 0), cA, voffA); PG8_STAGE(PG8_SA(0, 1), cA + hstepA, voffA);
        if (wr == 1) PG8_BAR;
        PG8_WAIT_V(2); PG8_BAR;
        PG8_STAGE(PG8_SB(1, 0), cB + kstep, voffB); PG8_STAGE(PG8_SA(1, 0), cA + kstep, voffA); PG8_STAGE(PG8_SB(1, 1), cB + hstepB + kstep, voffB);
        PG8_WAIT_V(6); PG8_BAR;
    } else {
        PG8_STAGE(PG8_SB(0, 0), cB, voffB); PG8_STAGE(PG8_SA(0, 0), cA, voffA); PG8_STAGE(PG8_SB(0, 1), cB + hstepB, voffB); PG8_STAGE(PG8_SA(0, 1), cA + hstepA, voffA);
        if (wr == 1) PG8_BAR;
        PG8_WAIT_V(4); PG8_BAR;
        PG8_STAGE(PG8_SB(1, 0), cB + kstep, voffB); PG8_STAGE(PG8_SA(1, 0), cA + kstep, voffA); PG8_STAGE(PG8_SB(1, 1), cB + hstepB + kstep, voffB);
        PG8_WAIT_V(6); PG8_BAR;
    }
    for (;;) {
        const bool has_next = S.next(ui + 1, nxt);
        const char* nA = has_next ? (const char*)g.A + (size_t)nxt.pm * tstepA + (size_t)nxt.ka * 2 : cA; const char* nB = has_next ? (const char*)g.Bt + (size_t)nxt.pn * tstepB + (size_t)nxt.kb * 2 : cB;
        for (int t = 0; t < nt; t += 2) {
            const bool last = (t == nt - 2);
            const char* a1 = cA + (size_t)(t + 1) * kstep;
            const char* a2 = last ? nA : cA + (size_t)(t + 2) * kstep; const char* b2 = last ? nB : cB + (size_t)(t + 2) * kstep;
            const char* a3 = a2 + kstep; const char* b3 = b2 + kstep;
            if (last && has_next) S.a_ready(nxt);
            if constexpr (SP2) {
            PG8_LDB(B0, 0, 0); PG8_LDB(B1, 0, 1); PG8_SCHED; PG8_LDA(At, 0, 0); PG8_STAGE(PG8_SA(1, 1), a1 + hstepA, voffA);
            PG8_WAIT_V(8); PG8_WAIT_L(0); PG8_BAR; PG8_MMA(0, 0, At, B0); PG8_MMA(0, 1, At, B1); PG8_BAR; PG8_SCHED;
            PG8_LDA(At, 0, 1); PG8_STAGE(PG8_SB(0, 0), b2, voffB); PG8_STAGE(PG8_SB(0, 1), b2 + hstepB, voffB); PG8_STAGE(PG8_SA(0, 0), a2, voffA);
            PG8_WAIT_V(8); PG8_WAIT_L(0); PG8_BAR; PG8_MMA(1, 0, At, B0); PG8_MMA(1, 1, At, B1); PG8_BAR; PG8_SCHED;
            PG8_LDB(B0, 1, 0); PG8_LDB(B1, 1, 1); PG8_SCHED; PG8_LDA(At, 1, 0); PG8_STAGE(PG8_SA(0, 1), a2 + hstepA, voffA);
            PG8_WAIT_V(8); PG8_WAIT_L(0); PG8_BAR; PG8_MMA(0, 0, At, B0); PG8_MMA(0, 1, At, B1); PG8_BAR; PG8_SCHED;
            PG8_LDA(At, 1, 1); PG8_STAGE(PG8_SB(1, 0), b3, voffB); PG8_STAGE(PG8_SB(1, 1), b3 + hstepB, voffB); PG8_STAGE(PG8_SA(1, 0), a3, voffA);
            PG8_WAIT_V(8); PG8_WAIT_L(0); PG8_BAR; PG8_MMA(1, 0, At, B0); PG8_MMA(1, 1, At, B1); PG8_BAR; PG8_SCHED;
            } else {
            PG8_LDB(B0, 0, 0); PG8_SCHED; PG8_LDA(At, 0, 0); PG8_STAGE(PG8_SA(1, 1), a1 + hstepA, voffA);
            PG8_WAIT_L(8); PG8_BAR; PG8_WAIT_L(0); PG8_MMA(0, 0, At, B0); PG8_BAR; PG8_SCHED;
            PG8_LDB(B1, 0, 1); PG8_STAGE(PG8_SB(0, 0), b2, voffB);
            PG8_BAR; PG8_WAIT_L(0); PG8_MMA(0, 1, At, B1); PG8_BAR;
            PG8_LDA(At, 0, 1); PG8_STAGE(PG8_SA(0, 0), a2, voffA);
            PG8_BAR; PG8_WAIT_L(0); PG8_MMA(1, 0, At, B0); PG8_BAR; PG8_SCHED;
            PG8_STAGE(PG8_SB(0, 1), b2 + hstepB, voffB);
            PG8_WAIT_V(6); PG8_BAR; PG8_MMA(1, 1, At, B1); PG8_BAR;
            PG8_LDB(B0, 1, 0); PG8_SCHED; PG8_LDA(At, 1, 0); PG8_STAGE(PG8_SA(0, 1), a2 + hstepA, voffA);
            PG8_WAIT_L(8); PG8_BAR; PG8_WAIT_L(0); PG8_MMA(0, 0, At, B0); PG8_BAR; PG8_SCHED;
            PG8_LDB(B1, 1, 1); PG8_STAGE(PG8_SB(1, 0), b3, voffB);
            PG8_BAR; PG8_WAIT_L(0); PG8_MMA(0, 1, At, B1); PG8_BAR;
            PG8_LDA(At, 1, 1); PG8_STAGE(PG8_SA(1, 0), a3, voffA);
            PG8_BAR; PG8_WAIT_L(0); PG8_MMA(1, 0, At, B0); PG8_BAR; PG8_SCHED;
            PG8_STAGE(PG8_SB(1, 1), b3 + hstepB, voffB);
            PG8_WAIT_V(6); PG8_BAR; PG8_MMA(1, 1, At, B1); PG8_BAR;
            }
        }
        if constexpr (ALIGN_EPI) { if (wr == 0) PG8_BAR; }
        if constexpr (!Epi::AFTER_DRAIN) { E(acc, cur, wr, wc, fr, fq); S.done(cur); }
        if (!has_next) break;
#pragma unroll
        for (int a = 0; a < 2; ++a)
#pragma unroll
            for (int b = 0; b < 2; ++b)
#pragma unroll
                for (int m = 0; m < 4; ++m)
#pragma unroll
                    for (int n = 0; n < 2; ++n) acc[a][b][m][n] = (f32x4){0.f, 0.f, 0.f, 0.f};
        cur = nxt; cA = nA; cB = nB; ++ui;
        if constexpr (ALIGN_EPI) { if (wr == 1) PG8_BAR; }
    }
    PG8_WAIT_V(0);
    if constexpr (!ALIGN_EPI) { if (wr == 0) PG8_BAR; }
    PG8_BAR;
    if constexpr (Epi::AFTER_DRAIN) { E.fused(acc, cur, wr, wc, fr, fq, lds, wid, lane); S.done(cur); }
#undef PG8_SA
#undef PG8_SB
#undef PG8_STAGE
#undef PG8_LDA
#undef PG8_LDB
#undef PG8_MMA
#undef PG8_WAIT_V
#undef PG8_WAIT_L
#undef PG8_BAR
#undef PG8_SCHED
}
}

constexpr int NWAVES = 8, NTHR = 512, GRID = 256;
constexpr int D = 4096, SEQ = 2048, NB = 4, M = NB * SEQ, FF = 4 * D;
constexpr int HY_IN = 10688, LDZ0 = 10752;
constexpr int ML_IN = 12304, LDZ1 = 12544;
constexpr int ZC_R = 4096, ZC_K = 6144, ZC_V = 8192, ZC_WL = 10240, ZC_AL = 10336, ZC_GL = 10432;
constexpr int MC_Q = 0, MC_K = 2048, MC_V = 4096, MC_O = 8192, MC_I = 12288, MC_F = 12296;
constexpr float NORM_EPS = 1e-6f, GN_EPS = 64e-5f;
constexpr int N_PHASES = 15;

constexpr size_t MiB = 1u << 20;
constexpr size_t WS_CTL = 0, CTL_ZERO_BYTES = 1 * MiB;
constexpr size_t WS_WHYIN = 1 * MiB;
constexpr size_t WS_WHYOUT = WS_WHYIN + (size_t)LDZ0 * D * 2;
constexpr size_t WS_WUP = WS_WHYOUT + (size_t)D * D * 2;
constexpr size_t WS_WDOWN = WS_WUP + 2 * (size_t)FF * D * 2;
constexpr size_t WS_WMLIN = WS_WDOWN + 2 * (size_t)FF * D * 2;
constexpr size_t WS_WMLOUT = WS_WMLIN + (size_t)LDZ1 * D * 2;
constexpr size_t WS_W2T = WS_WMLOUT + (size_t)D * D * 2;
constexpr size_t WS_A2T = WS_W2T + 2048 * 128 * 2;
constexpr size_t WS_G2T = WS_A2T + 2048 * 128 * 2;
constexpr size_t WS_XB = WS_G2T + 2048 * 256 * 2;
constexpr size_t WS_XF = WS_XB + (size_t)M * D * 2;
constexpr size_t WS_CAT = WS_XF + (size_t)M * D * 4;
constexpr size_t WS_SSQ = WS_CAT + (size_t)M * D * 2;
constexpr size_t WS_U = WS_SSQ + (size_t)M * 64 * 4;
constexpr size_t WS_Z = WS_U;
constexpr size_t WS_DEC = WS_U + (size_t)M * FF * 2;
constexpr size_t WS_AA = WS_DEC + (size_t)M * 2048 * 4;
constexpr size_t WS_GG = WS_AA + (size_t)M * 2048 * 4;
constexpr size_t WS_AW = WS_GG + (size_t)M * 2048 * 4;
constexpr size_t WS_AAL = WS_AW + (size_t)M * 128 * 2;
constexpr size_t WS_AG = WS_AAL + (size_t)M * 128 * 2;
constexpr size_t WS_HRAW = WS_DEC;
constexpr size_t WS_HSSQ = WS_GG;
constexpr size_t WS_END = WS_AG + (size_t)M * 256 * 2;
static_assert((size_t)M * LDZ1 * 2 <= (size_t)M * FF * 2, "Z fits in U's region");
static_assert(WS_HRAW + (size_t)M * D * 4 <= WS_GG, "HRAW fits in DEC|AA");
constexpr int CW_BAR = 4096;

constexpr int RING_BYTES = 131072;
constexpr int RS_OFF = RING_BYTES, RS_BYTES = 8192;
constexpr int LDSCTL_OFF = RS_OFF + RS_BYTES, MISC_OFF = LDSCTL_OFF + 320;
constexpr int LDS_BYTES = 147456;
static_assert(MISC_OFF + 128 <= LDS_BYTES, "LDS map");

#define GAS __attribute__((address_space(1)))
#define LAS __attribute__((address_space(3)))
typedef unsigned short bf16;
typedef unsigned v4u __attribute__((ext_vector_type(4)));
typedef unsigned v2u __attribute__((ext_vector_type(2)));
typedef float f32x4 __attribute__((ext_vector_type(4)));
typedef float f32x2 __attribute__((ext_vector_type(2)));
typedef GAS unsigned gu32;
#define RLX_AGENT __ATOMIC_RELAXED, __HIP_MEMORY_SCOPE_AGENT
#define LDS_WAIT() asm volatile("s_waitcnt lgkmcnt(0)" ::: "memory")
#define VM_WAIT() asm volatile("s_waitcnt vmcnt(0)" ::: "memory")
__device__ __forceinline__ unsigned f2bf(float f) { unsigned u = __builtin_bit_cast(unsigned, f); return (u + 0x7fffu + ((u >> 16) & 1u)) >> 16; }
__device__ __forceinline__ unsigned pk2(float lo, float hi) { return f2bf(lo) | (f2bf(hi) << 16); }
__device__ __forceinline__ float bflo(unsigned w) { return __builtin_bit_cast(float, w << 16); }
__device__ __forceinline__ float bfhi(unsigned w) { return __builtin_bit_cast(float, w & 0xffff0000u); }
__device__ __forceinline__ float bf2f(bf16 h) { return __builtin_bit_cast(float, (unsigned)h << 16); }
__device__ __forceinline__ float sigmoidf_(float x) { return 1.f / (1.f + expf(-x)); }
__device__ __forceinline__ float softplusf_(float x) { return fmaxf(x, 0.f) + log1pf(expf(-fabsf(x))); }
__device__ __forceinline__ float gelu_tanh(float x) { return 0.5f * x * (1.f + tanhf(0.7978845608028654f * (x + 0.044715f * x * x * x))); }
template <int CTRL> __device__ __forceinline__ float dpp_f(float v) { return __builtin_bit_cast(float, __builtin_amdgcn_update_dpp(0, __builtin_bit_cast(int, v), CTRL, 0xF, 0xF, false)); }
__device__ __forceinline__ float red4(float v) { v += dpp_f<0xB1>(v); v += dpp_f<0x4E>(v); return v; }
__device__ __forceinline__ float red8(float v) { v = red4(v); v += dpp_f<0x141>(v); return v; }
__device__ __forceinline__ float red16(float v) { v = red8(v); v += dpp_f<0x140>(v); return v; }


#define XB_TMO      128
#define XB_XCNT(j)  (256  + 64 * (j))
#define XB_XSUB(j)  (1280 + 64 * (j))
#define XB_XGEN(j)  (2304 + 64 * (j))
#define XB_TOP      3328
#define XB_TOPGEN   3392
#define XCD_BAR_WORDS 3456
#define XB_SPIN_CAP (1u << 18)

__device__ __forceinline__ unsigned xb_ld(unsigned* p)              { return __hip_atomic_load(p, __ATOMIC_RELAXED, __HIP_MEMORY_SCOPE_AGENT); }
__device__ __forceinline__ unsigned xb_add(unsigned* p, unsigned v) { return __hip_atomic_fetch_add(p, v, __ATOMIC_RELAXED, __HIP_MEMORY_SCOPE_AGENT); }
__device__ __forceinline__ unsigned xb_xcc_id() { return (unsigned)__builtin_amdgcn_s_getreg((3 << 11) | 20) & 0xFu; }
#define XB_SPIN(cond, bar) do { unsigned _sp = 0; while (cond) { __builtin_amdgcn_s_sleep(1); \
    if ((++_sp & 255u) == 0u) { if (xb_ld(&(bar)[XB_TMO])) break; if (_sp > XB_SPIN_CAP) { atomicAdd(&(bar)[XB_TMO], 1u); break; } } } } while (0)

struct XcdBarrier {
    unsigned* bar; unsigned x;
    volatile LAS unsigned* st;
};

__device__ __forceinline__ XcdBarrier xcd_barrier_post(unsigned* bar, volatile LAS unsigned* st) {
    XcdBarrier b; b.bar = bar; b.x = xb_xcc_id(); b.st = st;
    if (threadIdx.x == 0) (void)xb_add(&bar[XB_XCNT(b.x)], 1u);
    return b;
}
__device__ __forceinline__ void xcd_barrier_complete(unsigned* bar, unsigned x, unsigned& nloc, unsigned& nx) {
    const unsigned G = gridDim.x * gridDim.y * gridDim.z;
    unsigned sum, cnt, mine, sp = 0u;
    for (;;) {
        sum = 0u; cnt = 0u; mine = 0u;
#pragma unroll
        for (unsigned j = 0; j < 16; ++j) { const unsigned c = xb_ld(&bar[XB_XCNT(j)]); sum += c; cnt += (c > 0u) ? 1u : 0u; mine = (j == x) ? c : mine; }
        if (sum == G) break;
        __builtin_amdgcn_s_sleep(1);
        if ((++sp & 255u) == 0u) { if (xb_ld(&bar[XB_TMO])) break; if (sp > XB_SPIN_CAP) { atomicAdd(&bar[XB_TMO], 1u); break; } }
    }
    nloc = mine > 0u ? mine : 1u; nx = cnt > 0u ? cnt : 1u;
}

__device__ __forceinline__ void xcd_barrier(const XcdBarrier& b) {
    asm volatile("s_waitcnt vmcnt(0)" ::: "memory");
    __syncthreads();
    if (threadIdx.x == 0) {
        unsigned* bar = b.bar;
        __builtin_amdgcn_s_waitcnt(0);
        unsigned nloc = b.st[0], nx = b.st[1];
        if (nloc == 0u) { xcd_barrier_complete(bar, b.x, nloc, nx); b.st[0] = nloc; b.st[1] = nx; }
        const unsigned old = xb_add(&bar[XB_XSUB(b.x)], 1u);
        const unsigned gen = old / nloc;
        if (old + 1u == (gen + 1u) * nloc) {
            __builtin_amdgcn_fence(__ATOMIC_RELEASE, "agent");
            asm volatile("s_waitcnt vmcnt(0)" ::: "memory");
            const unsigned og = xb_add(&bar[XB_TOP], 1u);
            const unsigned tg = og / nx;
            if (og + 1u == (tg + 1u) * nx) xb_add(&bar[XB_TOPGEN], 1u);
            else XB_SPIN(xb_ld(&bar[XB_TOPGEN]) == tg, bar);
            __builtin_amdgcn_fence(__ATOMIC_ACQUIRE, "agent");
            xb_add(&bar[XB_XGEN(b.x)], 1u);
            asm volatile("s_waitcnt vmcnt(0)" ::: "memory");
        } else {
            XB_SPIN(xb_ld(&bar[XB_XGEN(b.x)]) == gen, bar);
            __builtin_amdgcn_fence(__ATOMIC_ACQUIRE, "agent");
            asm volatile("s_waitcnt vmcnt(0)" ::: "memory");
        }
    }
    __syncthreads();
}


struct Args { const float* in[31]; float* out; unsigned char* ws; int ph_lo, ph_hi; };
#define CAS __attribute__((address_space(4)))
enum { I_X = 0, I_NMIX, I_NMLP, I_NFIN, I_UP, I_DOWN, I_HYIN, I_CONVW, I_CONVB, I_WA, I_BA, I_WX, I_BX, I_LAM, I_MU, I_W0, I_W2, I_A0, I_A2, I_G2, I_KK, I_KA, I_RK,
       I_LNW, I_LNB, I_HYOUT, I_MLIN, I_BI, I_BF, I_MLNORM, I_MLOUT };

__device__ __forceinline__ float wave_sum(float v) {
#pragma unroll
    for (int o = 1; o < 64; o <<= 1) v += __shfl_xor(v, o);
    return v;
}

__device__ __forceinline__ void conv_item(const float* W, int K, int N, bf16* WT, int ldk, const float* gain, LAS float* scr, int kt, int ntile, int lane) {
    const int k0 = kt * 64, n0 = ntile * 64, nl = (lane & 15) * 4, n = n0 + nl;
#pragma unroll 4
    for (int i = 0; i < 16; ++i) { const int kl = i * 4 + (lane >> 4), k = k0 + kl;
        f32x4 v = (f32x4){0.f, 0.f, 0.f, 0.f};
        if (k < K && n < N) { v = *(const f32x4*)(W + (size_t)k * N + n); if (gain) v = v * gain[k]; }
        LAS float* s = scr + kl * 65 + nl; s[0] = v.x; s[1] = v.y; s[2] = v.z; s[3] = v.w; }
    LDS_WAIT(); asm volatile("" ::: "memory");
    const int c = lane & 7;
#pragma unroll
    for (int j = 0; j < 8; ++j) { const int r = j * 8 + (lane >> 3); const LAS float* s = scr + (8 * c) * 65 + r;
        v4u o; o.x = pk2(s[0], s[65]); o.y = pk2(s[130], s[195]); o.z = pk2(s[260], s[325]); o.w = pk2(s[390], s[455]);
        *(GAS v4u*)(WT + (size_t)(n0 + r) * ldk + k0 + 8 * c) = o; }
    LDS_WAIT(); asm volatile("" ::: "memory");
}
__device__ __forceinline__ void p0_prologue(LAS unsigned char* lds, const CAS Args* a, int vcu, int wave, int lane) {
    unsigned char* ws = a->ws;
    LAS float* scr = (LAS float*)(lds + wave * 16640);
    const int gw = vcu * NWAVES + wave, NGW = GRID * NWAVES;
#define CONV(Wp, K_, N_, NPAD_, WTp, LDK_, GAIN_) { constexpr int ntn = (NPAD_) / 64, cnt = ntn * ((LDK_) / 64); \
        if (r < cnt) { conv_item(Wp, K_, N_, (bf16*)(WTp), LDK_, GAIN_, scr, r / ntn, r % ntn, lane); continue; } r -= cnt; }
    constexpr int TOTAL = (LDZ0 / 64) * 64 + 64 * 64 + 2 * (FF / 64) * 64 + 2 * 64 * (FF / 64) + (LDZ1 / 64) * 64 + 64 * 64 + 32 * 2 + 32 * 2 + 32 * 4;
    for (int it = gw; it < TOTAL; it += NGW) {
        int r = it;
        CONV(a->in[I_UP], D, FF, FF, ws + WS_WUP, D, a->in[I_NMLP])
        CONV(a->in[I_UP] + (size_t)D * FF, D, FF, FF, ws + WS_WUP + (size_t)FF * D * 2, D, a->in[I_NMLP] + D)
        CONV(a->in[I_DOWN], FF, D, D, ws + WS_WDOWN, FF, (const float*)nullptr)
        CONV(a->in[I_DOWN] + (size_t)D * FF, FF, D, D, ws + WS_WDOWN + (size_t)FF * D * 2, FF, (const float*)nullptr)
        CONV(a->in[I_HYIN], D, HY_IN, LDZ0, ws + WS_WHYIN, D, a->in[I_NMIX])
        CONV(a->in[I_MLIN], D, ML_IN, LDZ1, ws + WS_WMLIN, D, a->in[I_NMIX] + D)
        CONV(a->in[I_HYOUT], D, D, D, ws + WS_WHYOUT, D, (const float*)nullptr)
        CONV(a->in[I_MLOUT], D, D, D, ws + WS_WMLOUT, D, (const float*)nullptr)
        CONV(a->in[I_W2], 96, 2048, 2048, ws + WS_W2T, 128, (const float*)nullptr)
        CONV(a->in[I_A2], 96, 2048, 2048, ws + WS_A2T, 128, (const float*)nullptr)
        CONV(a->in[I_G2], 256, 2048, 2048, ws + WS_G2T, 256, (const float*)nullptr)
    }
#undef CONV
    const float* x = a->in[I_X]; bf16* XB = (bf16*)(ws + WS_XB); float* SSQ = (float*)(ws + WS_SSQ);
    for (int m = gw; m < M; m += NGW) {
        const GAS f32x4* xr = (const GAS f32x4*)(x + (size_t)m * D) + lane; GAS v2u* o = (GAS v2u*)(XB + (size_t)m * D) + lane; float s = 0.f;
#pragma unroll
        for (int j = 0; j < 16; ++j) { const f32x4 v = xr[64 * j]; s += (v.x * v.x + v.y * v.y) + (v.z * v.z + v.w * v.w); v2u w; w.x = pk2(v.x, v.y); w.y = pk2(v.z, v.w); o[64 * j] = w; }
        s = wave_sum(s); if (lane == 0) SSQ[(size_t)m * 64] = s;
    }
}

template <class Sched> __device__ __forceinline__ void build_rs(LAS float* tab, const Sched& S, const float* ssq, int npart, int tid) {
    pg8::Unit u;
    for (int i = 0; i < 8 && S.next(i, u); ++i) {
        const int row = u.pm * 256 + (tid >> 1), half = tid & 1; float s = 0.f;
        if (npart == 64) { const GAS f32x4* p = (const GAS f32x4*)(ssq + (size_t)row * 64 + half * 32);
#pragma unroll
            for (int k = 0; k < 8; ++k) { const f32x4 v = p[k]; s += (v.x + v.y) + (v.z + v.w); } }
        else if (half == 0) s = ((const GAS float*)ssq)[(size_t)row * 64];
        s += __shfl_xor(s, 1);
        if (half == 0) tab[i * 256 + (tid >> 1)] = 1.0f / sqrtf(s * (1.0f / D) + NORM_EPS);
    }
    LDS_WAIT(); __syncthreads();
}

__device__ __forceinline__ void rwkv_prepass(const CAS Args* a, int gtid) {
    const bf16* Z = (const bf16*)(a->ws + WS_Z); bf16* AW = (bf16*)(a->ws + WS_AW); bf16* AAL = (bf16*)(a->ws + WS_AAL); bf16* AG = (bf16*)(a->ws + WS_AG);
    const float* mu = a->in[I_MU];
    for (int idx = gtid; idx < M * 64; idx += GRID * NTHR) {
        const int t = idx >> 6, cg = idx & 63;
        if (cg >= 56) { const int p = cg - 56; bf16* dst = (p < 4 ? AW : AAL) + (size_t)t * 128 + 96 + (p & 3) * 8; *(GAS v4u*)dst = (v4u){0u, 0u, 0u, 0u}; continue; }
        const bf16* zr = Z + (size_t)t * LDZ0 + ZC_WL + cg * 8;
        const v4u zc = *(const GAS v4u*)zr; v4u zp = (v4u){0u, 0u, 0u, 0u}; if ((t & (SEQ - 1)) != 0) zp = *(const GAS v4u*)(zr - LDZ0);
        const float* mp = mu + (ZC_WL - ZC_R) + cg * 8;
        float v[8];
#pragma unroll
        for (int i = 0; i < 4; ++i) { const float c0 = bflo(zc[i]), c1 = bfhi(zc[i]), p0 = bflo(zp[i]), p1 = bfhi(zp[i]);
            v[2 * i] = c0 + (p0 - c0) * mp[2 * i]; v[2 * i + 1] = c1 + (p1 - c1) * mp[2 * i + 1]; }
        bf16* dst;
        if (cg < 12) { dst = AW + (size_t)t * 128 + cg * 8;
#pragma unroll
            for (int i = 0; i < 8; ++i) v[i] = tanhf(v[i]); }
        else if (cg < 24) { dst = AAL + (size_t)t * 128 + (cg - 12) * 8; }
        else { dst = AG + (size_t)t * 256 + (cg - 24) * 8;
#pragma unroll
            for (int i = 0; i < 8; ++i) v[i] = sigmoidf_(v[i]); }
        v4u o; o.x = pk2(v[0], v[1]); o.y = pk2(v[2], v[3]); o.z = pk2(v[4], v[5]); o.w = pk2(v[6], v[7]);
        *(GAS v4u*)dst = o;
    }
}

struct RwkvRaw { v4u zr, zrp, zk, zkp, zv, zvp; f32x4 d0, d1, a0, a1, g0, g1; };
__device__ __forceinline__ void rwkv_load(RwkvRaw& R, const bf16* Z, const float* DEC, const float* AAp, const float* GG, int b, int h, int j, int ltt, int lcc) {
    const int tpos = j * 64 + ltt; const size_t g = (size_t)b * SEQ + tpos; const int c0 = h * 64 + lcc * 8;
    const bf16* zrow = Z + g * LDZ0 + c0;
    R.zr = *(const GAS v4u*)(zrow + ZC_R); R.zk = *(const GAS v4u*)(zrow + ZC_K); R.zv = *(const GAS v4u*)(zrow + ZC_V);
    if (tpos > 0) { R.zrp = *(const GAS v4u*)(zrow + ZC_R - LDZ0); R.zkp = *(const GAS v4u*)(zrow + ZC_K - LDZ0); R.zvp = *(const GAS v4u*)(zrow + ZC_V - LDZ0); }
    else { R.zrp = (v4u){0u, 0u, 0u, 0u}; R.zkp = R.zrp; R.zvp = R.zrp; }
    const GAS f32x4* dp = (const GAS f32x4*)(DEC + g * 2048 + c0); R.d0 = dp[0]; R.d1 = dp[1];
    const GAS f32x4* ap = (const GAS f32x4*)(AAp + g * 2048 + c0); R.a0 = ap[0]; R.a1 = ap[1];
    const GAS f32x4* gp = (const GAS f32x4*)(GG + g * 2048 + c0); R.g0 = gp[0]; R.g1 = gp[1];
}
__device__ __forceinline__ void rwkv_phase(LAS unsigned char* lds, const CAS Args* a, int bh, int tid) {
    LAS float* DW = (LAS float*)lds; LAS float* KK = DW + 4096; LAS float* KA = KK + 4096; LAS float* KT = KA + 4096; LAS float* RR = KT + 4096;
    LAS float* VV = RR + 4096; LAS float* YY = VV + 4096; LAS float* BD = YY + 4096;
    const bf16* Z = (const bf16*)(a->ws + WS_Z); const float* DEC = (const float*)(a->ws + WS_DEC); const float* AAp = (const float*)(a->ws + WS_AA); const float* GG = (const float*)(a->ws + WS_GG);
    bf16* CAT = (bf16*)(a->ws + WS_CAT);
    const float* mu = a->in[I_MU]; const float* k_k = a->in[I_KK]; const float* k_a = a->in[I_KA]; const float* r_k = a->in[I_RK]; const float* ln_w = a->in[I_LNW]; const float* ln_b = a->in[I_LNB];
    const int b = bh >> 5, h = bh & 31, lane = tid & 63, wave = tid >> 6;
    const int ltt = tid >> 3, lcc = tid & 7, c0 = h * 64 + lcc * 8;
    const int kseg = lane & 15, v0 = wave * 8 + (lane >> 4) * 2;
    float S0[4] = {0.f, 0.f, 0.f, 0.f}, S1[4] = {0.f, 0.f, 0.f, 0.f};
    RwkvRaw R; rwkv_load(R, Z, DEC, AAp, GG, b, h, 0, ltt, lcc);
    for (int j = 0; j < SEQ / 64; ++j) {
        f32x4 gk0 = R.g0, gk1 = R.g1;
        {
            float rs[8], ks[8], vs[8], kkr[8], av[8], dv[8];
#pragma unroll
            for (int i = 0; i < 4; ++i) {
                float c, p;
                c = bflo(R.zr[i]); p = bflo(R.zrp[i]); rs[2 * i] = c + (p - c) * mu[c0 + 2 * i];
                c = bfhi(R.zr[i]); p = bfhi(R.zrp[i]); rs[2 * i + 1] = c + (p - c) * mu[c0 + 2 * i + 1];
                c = bflo(R.zk[i]); p = bflo(R.zkp[i]); ks[2 * i] = c + (p - c) * mu[2048 + c0 + 2 * i];
                c = bfhi(R.zk[i]); p = bfhi(R.zkp[i]); ks[2 * i + 1] = c + (p - c) * mu[2048 + c0 + 2 * i + 1];
                c = bflo(R.zv[i]); p = bflo(R.zvp[i]); vs[2 * i] = c + (p - c) * mu[4096 + c0 + 2 * i];
                c = bfhi(R.zv[i]); p = bfhi(R.zvp[i]); vs[2 * i + 1] = c + (p - c) * mu[4096 + c0 + 2 * i + 1];
            }
#pragma unroll
            for (int i = 0; i < 4; ++i) { av[i] = R.a0[i]; av[4 + i] = R.a1[i]; dv[i] = R.d0[i]; dv[4 + i] = R.d1[i]; }
            float q = 0.f;
#pragma unroll
            for (int i = 0; i < 8; ++i) { kkr[i] = ks[i] * k_k[c0 + i]; q += kkr[i] * kkr[i]; }
            q = red8(q);
            const float inv = 1.0f / fmaxf(sqrtf(q), 1e-12f);
            float bd = 0.f; float kt[8], ka[8];
#pragma unroll
            for (int i = 0; i < 8; ++i) { kkr[i] *= inv; kt[i] = ks[i] * (1.f + (av[i] - 1.f) * k_a[c0 + i]); ka[i] = kkr[i] * av[i]; bd += rs[i] * kt[i] * r_k[c0 + i]; }
            bd = red8(bd);
            const int o = ltt * 64 + lcc * 8;
            *(LAS f32x4*)(DW + o) = (f32x4){dv[0], dv[1], dv[2], dv[3]}; *(LAS f32x4*)(DW + o + 4) = (f32x4){dv[4], dv[5], dv[6], dv[7]};
            *(LAS f32x4*)(KK + o) = (f32x4){kkr[0], kkr[1], kkr[2], kkr[3]}; *(LAS f32x4*)(KK + o + 4) = (f32x4){kkr[4], kkr[5], kkr[6], kkr[7]};
            *(LAS f32x4*)(KA + o) = (f32x4){ka[0], ka[1], ka[2], ka[3]}; *(LAS f32x4*)(KA + o + 4) = (f32x4){ka[4], ka[5], ka[6], ka[7]};
            *(LAS f32x4*)(KT + o) = (f32x4){kt[0], kt[1], kt[2], kt[3]}; *(LAS f32x4*)(KT + o + 4) = (f32x4){kt[4], kt[5], kt[6], kt[7]};
            *(LAS f32x4*)(RR + o) = (f32x4){rs[0], rs[1], rs[2], rs[3]}; *(LAS f32x4*)(RR + o + 4) = (f32x4){rs[4], rs[5], rs[6], rs[7]};
            *(LAS f32x4*)(VV + o) = (f32x4){vs[0], vs[1], vs[2], vs[3]}; *(LAS f32x4*)(VV + o + 4) = (f32x4){vs[4], vs[5], vs[6], vs[7]};
            if (lcc == 0) BD[ltt] = bd;
        }
        LDS_WAIT(); __syncthreads();
        if (j + 1 < SEQ / 64) rwkv_load(R, Z, DEC, AAp, GG, b, h, j + 1, ltt, lcc);
#pragma unroll 2
        for (int tt = 0; tt < 64; ++tt) {
            const int o = tt * 64 + kseg * 4;
            const f32x4 kk4 = *(const LAS f32x4*)(KK + o), w4 = *(const LAS f32x4*)(DW + o), ka4 = *(const LAS f32x4*)(KA + o), kt4 = *(const LAS f32x4*)(KT + o), r4 = *(const LAS f32x4*)(RR + o);
            const f32x2 vv = *(const LAS f32x2*)(VV + tt * 64 + v0);
            float sa0 = (S0[0] * kk4[0] + S0[1] * kk4[1]) + (S0[2] * kk4[2] + S0[3] * kk4[3]);
            float sa1 = (S1[0] * kk4[0] + S1[1] * kk4[1]) + (S1[2] * kk4[2] + S1[3] * kk4[3]);
            sa0 = red16(sa0); sa1 = red16(sa1);
            float y0 = 0.f, y1 = 0.f;
#pragma unroll
            for (int e = 0; e < 4; ++e) {
                S0[e] = S0[e] * w4[e] + (vv.x * kt4[e] - sa0 * ka4[e]);
                S1[e] = S1[e] * w4[e] + (vv.y * kt4[e] - sa1 * ka4[e]);
                y0 += S0[e] * r4[e]; y1 += S1[e] * r4[e];
            }
            y0 = red16(y0); y1 = red16(y1);
            if (kseg == 0) *(LAS f32x2*)(YY + tt * 64 + v0) = (f32x2){y0, y1};
        }
        LDS_WAIT(); __syncthreads();
        {
            const int o = ltt * 64 + lcc * 8; const size_t g = (size_t)b * SEQ + j * 64 + ltt;
            const f32x4 ya = *(const LAS f32x4*)(YY + o), yb = *(const LAS f32x4*)(YY + o + 4), va = *(const LAS f32x4*)(VV + o), vb = *(const LAS f32x4*)(VV + o + 4);
            float y[8] = {ya[0], ya[1], ya[2], ya[3], yb[0], yb[1], yb[2], yb[3]}, vq[8] = {va[0], va[1], va[2], va[3], vb[0], vb[1], vb[2], vb[3]};
            float gq[8] = {gk0[0], gk0[1], gk0[2], gk0[3], gk1[0], gk1[1], gk1[2], gk1[3]};
            float s = 0.f;
#pragma unroll
            for (int i = 0; i < 8; ++i) s += y[i];
            const float mean = red8(s) * (1.f / 64.f); float q = 0.f;
#pragma unroll
            for (int i = 0; i < 8; ++i) { y[i] -= mean; q += y[i] * y[i]; }
            const float rstd = 1.0f / sqrtf(red8(q) * (1.f / 64.f) + GN_EPS), bd = BD[ltt];
            float ov[8];
#pragma unroll
            for (int i = 0; i < 8; ++i) ov[i] = (y[i] * rstd * ln_w[c0 + i] + ln_b[c0 + i] + bd * vq[i]) * gq[i];
            v4u w; w.x = pk2(ov[0], ov[1]); w.y = pk2(ov[2], ov[3]); w.z = pk2(ov[4], ov[5]); w.w = pk2(ov[6], ov[7]);
            *(GAS v4u*)(CAT + g * D + 2048 + c0) = w;
        }
        LDS_WAIT(); __syncthreads();
    }
}

__device__ __forceinline__ void rglru_phase(LAS unsigned char* lds, const CAS Args* a, int w, int tid) {
    LAS float* UC = (LAS float*)lds;
    LAS float* A_ = UC + 64 * 256;
    LAS float* B_ = A_ + 4096;
    LAS float* G_ = B_ + 4096;
    const bf16* Z = (const bf16*)(a->ws + WS_Z); bf16* CAT = (bf16*)(a->ws + WS_CAT);
    const float* cw = a->in[I_CONVW]; const float* cb = a->in[I_CONVB]; const float* WA = a->in[I_WA]; const float* WX = a->in[I_WX];
    const float* ba = a->in[I_BA]; const float* bx = a->in[I_BX]; const float* lam = a->in[I_LAM];
    const int b = w >> 5, hh = (w >> 2) & 7, slab = w & 3;
    const int cc = tid & 255, chalf = tid >> 8;
    const int jch = tid & 63, tg = tid >> 6, c = hh * 256 + slab * 64 + jch;
    const float cw0 = cw[0 * 2048 + hh * 256 + cc], cw1 = cw[1 * 2048 + hh * 256 + cc], cw2 = cw[2 * 2048 + hh * 256 + cc], cw3 = cw[3 * 2048 + hh * 256 + cc], cbv = cb[hh * 256 + cc];
    const float sp = softplusf_(-lam[c]), bav = ba[c], bxv = bx[c];
    const float* wap = WA + (size_t)hh * 65536 + slab * 64 + jch; const float* wxp = WX + (size_t)hh * 65536 + slab * 64 + jch;
    float hstate = 0.f;
    for (int j = 0; j < SEQ / 64; ++j) {
        for (int tt = chalf; tt < 64; tt += 2) {
            const int tpos = j * 64 + tt; const bf16* zp = Z + ((size_t)b * SEQ + tpos) * LDZ0 + hh * 256 + cc;
            float acc = cbv + cw3 * bf2f(*(const GAS bf16*)zp);
            if (tpos >= 1) acc += cw2 * bf2f(*(const GAS bf16*)(zp - LDZ0));
            if (tpos >= 2) acc += cw1 * bf2f(*(const GAS bf16*)(zp - 2 * LDZ0));
            if (tpos >= 3) acc += cw0 * bf2f(*(const GAS bf16*)(zp - 3 * LDZ0));
            UC[tt * 256 + cc] = acc;
        }
        LDS_WAIT(); __syncthreads();
        float accA[8], accX[8];
#pragma unroll
        for (int t8 = 0; t8 < 8; ++t8) { accA[t8] = 0.f; accX[t8] = 0.f; }
        for (int i = 0; i < 256; i += 4) {
            const float wa0 = wap[(size_t)(i + 0) * 256], wa1 = wap[(size_t)(i + 1) * 256], wa2 = wap[(size_t)(i + 2) * 256], wa3 = wap[(size_t)(i + 3) * 256];
            const float wx0 = wxp[(size_t)(i + 0) * 256], wx1 = wxp[(size_t)(i + 1) * 256], wx2 = wxp[(size_t)(i + 2) * 256], wx3 = wxp[(size_t)(i + 3) * 256];
#pragma unroll
            for (int t8 = 0; t8 < 8; ++t8) { const f32x4 u = *(const LAS f32x4*)(UC + (tg * 8 + t8) * 256 + i);
                accA[t8] += (u[0] * wa0 + u[1] * wa1) + (u[2] * wa2 + u[3] * wa3);
                accX[t8] += (u[0] * wx0 + u[1] * wx1) + (u[2] * wx2 + u[3] * wx3); }
        }
#pragma unroll
        for (int t8 = 0; t8 < 8; ++t8) { const int tt = tg * 8 + t8;
            const float rg = sigmoidf_(accA[t8] + bav), ig = sigmoidf_(accX[t8] + bxv), la = -8.0f * rg * sp;
            const float av = expf(la), bv = sqrtf(-expm1f(2.0f * la)) * (ig * UC[tt * 256 + slab * 64 + jch]);
            const float gz = bf2f(*(const GAS bf16*)(Z + ((size_t)b * SEQ + j * 64 + tt) * LDZ0 + 2048 + c));
            A_[tt * 64 + jch] = av; B_[tt * 64 + jch] = bv; G_[tt * 64 + jch] = gelu_tanh(gz); }
        LDS_WAIT(); __syncthreads();
        if (tid < 64) {
#pragma unroll 4
            for (int tt = 0; tt < 64; ++tt) { hstate = A_[tt * 64 + tid] * hstate + B_[tt * 64 + tid]; A_[tt * 64 + tid] = hstate * G_[tt * 64 + tid]; }
        }
        LDS_WAIT(); __syncthreads();
        { const int tt = tid >> 3, c8 = (tid & 7) * 8; const f32x4 p = *(const LAS f32x4*)(A_ + tt * 64 + c8), q = *(const LAS f32x4*)(A_ + tt * 64 + c8 + 4);
          v4u o; o.x = pk2(p[0], p[1]); o.y = pk2(p[2], p[3]); o.z = pk2(q[0], q[1]); o.w = pk2(q[2], q[3]);
          *(GAS v4u*)(CAT + ((size_t)b * SEQ + j * 64 + tt) * D + hh * 256 + slab * 64 + c8) = o; }
        LDS_WAIT(); __syncthreads();
    }
}

struct MlRaw { v4u q0, q1, k0, k1; v2u v; unsigned gi, gf; };
__device__ __forceinline__ void ml_load(MlRaw& R, const bf16* Z, int b, int h, int sl, int j, int ltt, int c16) {
    const bf16* zrow = Z + ((size_t)b * SEQ + j * 32 + ltt) * LDZ1;
    const GAS v4u* qp = (const GAS v4u*)(zrow + MC_Q + h * 256 + c16 * 16); R.q0 = qp[0]; R.q1 = qp[1];
    const GAS v4u* kp = (const GAS v4u*)(zrow + MC_K + h * 256 + c16 * 16); R.k0 = kp[0]; R.k1 = kp[1];
    R.v = *(const GAS v2u*)(zrow + MC_V + h * 512 + sl * 64 + c16 * 4);
    R.gi = *(const GAS bf16*)(zrow + MC_I + h); R.gf = *(const GAS bf16*)(zrow + MC_F + h);
}
__device__ __forceinline__ void mlstm_phase(LAS unsigned char* lds, const CAS Args* a, int w, int tid) {
    LAS float* KF = (LAS float*)lds;
    LAS float* QF = KF + 8192;
    LAS float* VF = QF + 8192;
    LAS float* NUM = VF + 2048;
    LAS float* LI = NUM + 2048; LAS float* LF = LI + 32; LAS float* DEN = LF + 32; LAS float* MT = DEN + 32;
    const bf16* Z = (const bf16*)(a->ws + WS_Z); float* HRAW = (float*)(a->ws + WS_HRAW); float* HSSQ = (float*)(a->ws + WS_HSSQ);
    const int bh = w >> 3, sl = w & 7, b = bh >> 3, h = bh & 7, lane = tid & 63, wave = __builtin_amdgcn_readfirstlane(tid >> 6);
    const int ltt = tid >> 4, c16 = tid & 15;
    const int dvl = tid >> 3, seg = tid & 7;
    const float bi = a->in[I_BI][h], bfv = a->in[I_BF][h];
    float C[32], nst[32];
#pragma unroll
    for (int i = 0; i < 32; ++i) { C[i] = 0.f; nst[i] = 0.f; }
    float mrun = 0.f;
    MlRaw R; ml_load(R, Z, b, h, sl, 0, ltt, c16);
    for (int j = 0; j < SEQ / 32; ++j) {
        {
            const int o = ltt * 256 + c16 * 16;
            float qv[16], kv[16];
#pragma unroll
            for (int i = 0; i < 4; ++i) { qv[2 * i] = bflo(R.q0[i]); qv[2 * i + 1] = bfhi(R.q0[i]); qv[8 + 2 * i] = bflo(R.q1[i]); qv[8 + 2 * i + 1] = bfhi(R.q1[i]);
                                          kv[2 * i] = bflo(R.k0[i]); kv[2 * i + 1] = bfhi(R.k0[i]); kv[8 + 2 * i] = bflo(R.k1[i]); kv[8 + 2 * i + 1] = bfhi(R.k1[i]); }
#pragma unroll
            for (int i = 0; i < 4; ++i) { *(LAS f32x4*)(QF + o + 4 * i) = (f32x4){qv[4 * i] * 0.0625f, qv[4 * i + 1] * 0.0625f, qv[4 * i + 2] * 0.0625f, qv[4 * i + 3] * 0.0625f};
                                          *(LAS f32x4*)(KF + o + 4 * i) = (f32x4){kv[4 * i], kv[4 * i + 1], kv[4 * i + 2], kv[4 * i + 3]}; }
            *(LAS f32x4*)(VF + ltt * 64 + c16 * 4) = (f32x4){bflo(R.v[0]), bfhi(R.v[0]), bflo(R.v[1]), bfhi(R.v[1])};
            if (c16 == 0) { LI[ltt] = bf2f((bf16)R.gi) + bi; LF[ltt] = -softplusf_(-(bf2f((bf16)R.gf) + bfv)); }
        }
        LDS_WAIT(); __syncthreads();
        if (j + 1 < SEQ / 32) ml_load(R, Z, b, h, sl, j + 1, ltt, c16);
        for (int tt = 0; tt < 32; ++tt) {
            const float li = LI[tt], lf = LF[tt];
            const float mn = fmaxf(lf + mrun, li), fd = expf(lf + mrun - mn), ig = expf(li - mn); mrun = mn;
            const float vv = VF[tt * 64 + dvl] * ig;
            float acc = 0.f, dacc = 0.f;
            const LAS f32x4* kp = (const LAS f32x4*)(KF + tt * 256 + seg * 32); const LAS f32x4* qp = (const LAS f32x4*)(QF + tt * 256 + seg * 32);
#pragma unroll
            for (int i4 = 0; i4 < 8; ++i4) { const f32x4 k4 = kp[i4], q4 = qp[i4];
#pragma unroll
                for (int e = 0; e < 4; ++e) { const int i = i4 * 4 + e; C[i] = fd * C[i] + k4[e] * vv; acc += q4[e] * C[i]; }
                if (wave == 0) {
#pragma unroll
                    for (int e = 0; e < 4; ++e) { const int i = i4 * 4 + e; nst[i] = fd * nst[i] + k4[e] * ig; dacc += q4[e] * nst[i]; } }
            }
            acc = red8(acc);
            if (seg == 0) NUM[tt * 64 + dvl] = acc;
            if (wave == 0) { dacc = red8(dacc); if (lane == 0) { DEN[tt] = dacc; MT[tt] = mn; } }
        }
        LDS_WAIT(); __syncthreads();
        {
            const size_t g = (size_t)b * SEQ + j * 32 + ltt;
            const float den = DEN[ltt], e = expf(-MT[ltt]), dinv = 1.0f / fmaxf(fabsf(den), e);
            f32x4 hv = *(const LAS f32x4*)(NUM + ltt * 64 + c16 * 4); hv = hv * dinv;
            *(GAS f32x4*)(HRAW + g * D + h * 512 + sl * 64 + c16 * 4) = hv;
            float q = (hv[0] * hv[0] + hv[1] * hv[1]) + (hv[2] * hv[2] + hv[3] * hv[3]);
            q = red16(q);
            if (c16 == 0) HSSQ[g * 64 + h * 8 + sl] = q;
        }
        LDS_WAIT(); __syncthreads();
    }
}
__device__ __forceinline__ void mlstm_post(const CAS Args* a, int gtid) {
    const bf16* Z = (const bf16*)(a->ws + WS_Z); const float* HRAW = (const float*)(a->ws + WS_HRAW); const float* HSSQ = (const float*)(a->ws + WS_HSSQ); bf16* CAT = (bf16*)(a->ws + WS_CAT);
    const float* nw = a->in[I_MLNORM];
    for (int idx = gtid; idx < M * 512; idx += GRID * NTHR) {
        const int t = idx >> 9, c8 = (idx & 511) * 8, hd = c8 >> 9;
        const GAS f32x4* sp = (const GAS f32x4*)(HSSQ + (size_t)t * 64 + hd * 8); const f32x4 s0 = sp[0], s1 = sp[1];
        const float rs = 1.0f / sqrtf(((s0[0] + s0[1]) + (s0[2] + s0[3]) + (s1[0] + s1[1]) + (s1[2] + s1[3])) * (1.f / 512.f) + NORM_EPS);
        const GAS f32x4* hp = (const GAS f32x4*)(HRAW + (size_t)t * D + c8); const f32x4 h0 = hp[0], h1 = hp[1];
        const v4u zo = *(const GAS v4u*)(Z + (size_t)t * LDZ1 + MC_O + c8);
        float o[8];
#pragma unroll
        for (int i = 0; i < 4; ++i) { o[i] = h0[i] * rs * nw[c8 + i]; o[4 + i] = h1[i] * rs * nw[c8 + 4 + i]; }
#pragma unroll
        for (int i = 0; i < 4; ++i) { o[2 * i] *= sigmoidf_(bflo(zo[i])); o[2 * i + 1] *= sigmoidf_(bfhi(zo[i])); }
        v4u w; w.x = pk2(o[0], o[1]); w.y = pk2(o[2], o[3]); w.z = pk2(o[4], o[5]); w.w = pk2(o[6], o[7]);
        *(GAS v4u*)(CAT + (size_t)t * D + c8) = w;
    }
}
__device__ __forceinline__ void final_norm(const CAS Args* a, int vcu, int wave, int lane) {
    const float* gw_ = a->in[I_NFIN]; const int gw = vcu * NWAVES + wave, NGW = GRID * NWAVES;
    for (int m = gw; m < M; m += NGW) {
        GAS f32x4* xr = (GAS f32x4*)(a->out + (size_t)m * D) + lane; f32x4 v[16]; float s = 0.f;
#pragma unroll
        for (int j = 0; j < 16; ++j) { v[j] = xr[64 * j]; s += (v[j].x * v[j].x + v[j].y * v[j].y) + (v[j].z * v[j].z + v[j].w * v[j].w); }
        const float rstd = 1.0f / sqrtf(wave_sum(s) * (1.0f / D) + NORM_EPS);
#pragma unroll
        for (int j = 0; j < 16; ++j) { const f32x4 g4 = *(const f32x4*)(gw_ + 4 * (lane + 64 * j)); xr[64 * j] = v[j] * rstd * g4; }
    }
}

__device__ __forceinline__ const CAS Args* fresh_args() { const CAS Args* p = (const CAS Args*)__builtin_amdgcn_kernarg_segment_ptr(); asm volatile("" : "+s"(p)); return p; }
__device__ __forceinline__ bool in_phase(int k) { const CAS Args* p = fresh_args(); return p->ph_lo <= k && k < p->ph_hi; }
__device__ __forceinline__ int fresh_tid() { int t = threadIdx.x; asm volatile("" : "+v"(t)); return t; }
__device__ __forceinline__ int vcu_of() { const int bx = blockIdx.x; return (bx % 8) * (GRID / 8) + bx / 8; }
__device__ __forceinline__ void seam(LAS unsigned char* lds, int k) {
    if (MK_N_LAUNCHES != 1) return;
    if (in_phase(k) && in_phase(k + 1)) { const CAS Args* a = fresh_args(); XcdBarrier bar; bar.bar = (unsigned*)(a->ws + WS_CTL) + CW_BAR; bar.x = xb_xcc_id(); bar.st = (volatile LAS unsigned*)(lds + MISC_OFF) + 8; xcd_barrier(bar); }
}
template <int L> __device__ __forceinline__ void layer_phases(LAS unsigned char* lds) {
    constexpr int p_in = 1 + 7 * L, p_out = 5 + 6 * L, p_up = 6 + 6 * L, p_down = 7 + 6 * L;
    if (in_phase(p_in)) {
        const CAS Args* a = fresh_args(); unsigned char* ws = a->ws; const int tid = fresh_tid(); constexpr int ldz = L ? LDZ1 : LDZ0;
        pg8::Gemm g{(const bf16*)(ws + WS_XB), (const bf16*)(ws + (L ? WS_WMLIN : WS_WHYIN)), D, D, D};
        pg8::StaticOrder S; S.init(M, ldz, GRID, blockIdx.x);
        LAS float* rstab = (LAS float*)(lds + RS_OFF);
        build_rs(rstab, S, (const float*)(ws + WS_SSQ), L ? 64 : 1, tid);
        pg8::EpiScale<0> E{(bf16*)(ws + WS_Z), ldz, rstab};
        pg8::gemm_phase<pg8::EpiScale<0>, pg8::StaticOrder, true, true>(lds, g, S, E);
    }
    seam(lds, p_in);
    if (L == 0) {
        if (in_phase(2)) rwkv_prepass(fresh_args(), vcu_of() * NTHR + fresh_tid());
        seam(lds, 2);
        if (in_phase(3)) {
            for (int q = 0; q < 3; ++q) {
                const CAS Args* a = fresh_args(); unsigned char* ws = a->ws;
                const int kq = (q == 2) ? 256 : 128;
                pg8::Gemm g{(const bf16*)(ws + (q == 0 ? WS_AW : (q == 1 ? WS_AAL : WS_AG))), (const bf16*)(ws + (q == 0 ? WS_W2T : (q == 1 ? WS_A2T : WS_G2T))), kq, kq, kq};
                pg8::StaticOrder S; S.init(M, 2048, GRID, blockIdx.x);
                pg8::EpiLora E{(float*)(ws + (q == 0 ? WS_DEC : (q == 1 ? WS_AA : WS_GG))), 2048, q == 0 ? a->in[I_W0] : a->in[I_A0], q};
                pg8::gemm_phase<pg8::EpiLora, pg8::StaticOrder, true, true>(lds, g, S, E);
            }
        }
        seam(lds, 3);
        if (in_phase(4)) { const int vcu = vcu_of(); if (vcu < 128) rwkv_phase(lds, fresh_args(), vcu, fresh_tid()); else rglru_phase(lds, fresh_args(), vcu - 128, fresh_tid()); }
        seam(lds, 4);
    } else {
        if (in_phase(9)) mlstm_phase(lds, fresh_args(), vcu_of(), fresh_tid());
        seam(lds, 9);
        if (in_phase(10)) mlstm_post(fresh_args(), vcu_of() * NTHR + fresh_tid());
        seam(lds, 10);
    }
    if (in_phase(p_out)) {
        const CAS Args* a = fresh_args(); unsigned char* ws = a->ws;
        pg8::Gemm g{(const bf16*)(ws + WS_CAT), (const bf16*)(ws + (L ? WS_WMLOUT : WS_WHYOUT)), D, D, D};
        pg8::StaticOrder S; S.init(M, D, GRID, blockIdx.x);
        pg8::EpiResid E{L ? (const float*)(ws + WS_XF) : a->in[I_X], (float*)(ws + WS_XF), (bf16*)(ws + WS_XB), (float*)(ws + WS_SSQ), D};
        pg8::gemm_phase<pg8::EpiResid, pg8::StaticOrder, true, true>(lds, g, S, E);
    }
    seam(lds, p_out);
    if (in_phase(p_up)) {
        const CAS Args* a = fresh_args(); unsigned char* ws = a->ws; const int tid = fresh_tid();
        pg8::Gemm g{(const bf16*)(ws + WS_XB), (const bf16*)(ws + WS_WUP + (size_t)L * FF * D * 2), D, D, D};
        pg8::StaticOrder S; S.init(M, FF, GRID, blockIdx.x);
        LAS float* rstab = (LAS float*)(lds + RS_OFF);
        build_rs(rstab, S, (const float*)(ws + WS_SSQ), 64, tid);
        pg8::EpiScale<1> E{(bf16*)(ws + WS_U), FF, rstab};
        pg8::gemm_phase<pg8::EpiScale<1>, pg8::StaticOrder, true, true>(lds, g, S, E);
    }
    seam(lds, p_up);
    if (in_phase(p_down)) {
        const CAS Args* a = fresh_args(); unsigned char* ws = a->ws;
        pg8::Gemm g{(const bf16*)(ws + WS_U), (const bf16*)(ws + WS_WDOWN + (size_t)L * FF * D * 2), FF, FF, FF};
        pg8::StaticOrder S; S.init(M, D, GRID, blockIdx.x);
        pg8::EpiResid E{(const float*)(ws + WS_XF), L ? a->out : (float*)(ws + WS_XF), (bf16*)(ws + WS_XB), (float*)(ws + WS_SSQ), D};
        pg8::gemm_phase<pg8::EpiResid, pg8::StaticOrder, true, true>(lds, g, S, E);
    }
    seam(lds, p_down);
}
__global__ void __launch_bounds__(NTHR, 2) fwd_kernel(Args args) {
    extern __shared__ __attribute__((aligned(16))) unsigned char lds_raw[];
    LAS unsigned char* lds = (LAS unsigned char*)lds_raw;
    { const int tid = threadIdx.x;
      for (int u = tid; u < (LDS_BYTES - LDSCTL_OFF) / 4; u += NTHR) ((LAS unsigned*)(lds + LDSCTL_OFF))[u] = 0u;
      __syncthreads();
      if (MK_N_LAUNCHES == 1) { const CAS Args* a = fresh_args(); (void)xcd_barrier_post((unsigned*)(a->ws + WS_CTL) + CW_BAR, (volatile LAS unsigned*)(lds + MISC_OFF) + 8); } }
    if (in_phase(0)) { const int tid = fresh_tid(); p0_prologue(lds, fresh_args(), vcu_of(), __builtin_amdgcn_readfirstlane(tid >> 6), tid & 63); }
    seam(lds, 0);
    layer_phases<0>(lds);
    layer_phases<1>(lds);
    if (in_phase(14)) { const int tid = fresh_tid(); final_norm(fresh_args(), vcu_of(), __builtin_amdgcn_readfirstlane(tid >> 6), tid & 63); }
}

extern "C" void kernel_launch(void* const* d_in, const int* in_sizes, int n_in, void* d_out, int out_size, void* d_ws, size_t ws_size, hipStream_t stream) {
    static int ready = 0;
    if (ready == 0) {
        if (n_in != 31 || out_size != M * D || ws_size < WS_END) { fprintf(stderr, "kernel_launch: unexpected shapes (n_in %d, out %d, ws %zu < %zu); nothing launched\n", n_in, out_size, ws_size, (size_t)WS_END); ready = -1; return; }
        if (hipFuncSetAttribute((const void*)fwd_kernel, hipFuncAttributeMaxDynamicSharedMemorySize, LDS_BYTES) != hipSuccess) { fprintf(stderr, "kernel_launch: hipFuncSetAttribute failed\n"); ready = -1; return; }
        int per_cu = 0;
        if (hipOccupancyMaxActiveBlocksPerMultiprocessor(&per_cu, (const void*)fwd_kernel, NTHR, LDS_BYTES) != hipSuccess || per_cu < 1)
            fprintf(stderr, "kernel_launch: note: occupancy query reports %d workgroups per CU\n", per_cu);
        (void)hipGetLastError();
        ready = 1;
    }
    if (ready < 0) return;
    if (hipMemsetAsync((char*)d_ws + WS_CTL, 0, CTL_ZERO_BYTES, stream) != hipSuccess) { fprintf(stderr, "kernel_launch: memset failed\n"); return; }
    Args a{};
    for (int i = 0; i < 31; ++i) a.in[i] = (const float*)d_in[i];
    a.out = (float*)d_out; a.ws = (unsigned char*)d_ws;
    if (MK_N_LAUNCHES == 1) { a.ph_lo = 0; a.ph_hi = N_PHASES; hipLaunchKernelGGL(fwd_kernel, dim3(GRID), dim3(NTHR), LDS_BYTES, stream, a); }
    else { for (int p = 0; p < N_PHASES; ++p) { a.ph_lo = p; a.ph_hi = p + 1; hipLaunchKernelGGL(fwd_kernel, dim3(GRID), dim3(NTHR), LDS_BYTES, stream, a); } }
    const hipError_t le = hipPeekAtLastError();
    if (le != hipSuccess) fprintf(stderr, "kernel_launch: launch failed: %s\n", hipGetErrorName(le));
}
```

```cpp
#include <hip/hip_runtime.h>
#include <cstdio>
#include <cstdint>

#ifndef MK_N_LAUNCHES
#define MK_N_LAUNCHES 1
#endif

namespace pg8 {
#define PG8_LAS __attribute__((address_space(3)))
typedef unsigned short bf16_t;
typedef short bf16x8 __attribute__((ext_vector_type(8)));
typedef float f32x4 __attribute__((ext_vector_type(4)));
typedef unsigned u32x4 __attribute__((ext_vector_type(4)));
typedef unsigned u32x2 __attribute__((ext_vector_type(2)));
constexpr int BM = 256, BK = 64, HALF = 128, HTB = HALF * BK * 2  , STAGE_BYTES = 8 * HTB, NXCD = 8, WGM = 8;

__host__ __device__ __forceinline__ int lds_byte(int r, int c) { const int st = (r >> 4) * 2 + (c >> 5), rr = r & 15, cc = c & 31, ob = rr * 64 + cc * 2; return st * 1024 + (ob ^ (((ob >> 9) & 1) << 5)); }
__host__ __device__ __forceinline__ void stage_rc(int b, int& R, int& C) { const int st = b / 1024, sb = b % 1024, swz = sb ^ (((sb >> 9) & 1) << 5); R = (st >> 1) * 16 + swz / 64; C = (st & 1) * 32 + (swz % 64) / 2; }
__host__ __device__ __forceinline__ int perm32(int rho) { const int n = rho >> 4, i = rho & 15; return 8 * (i >> 2) + 4 * n + (i & 3); }

struct Unit { int pm, pn, ka, kb, ui, ks; };
struct Gemm { const bf16_t* A; const bf16_t* Bt; int lda, ldb, K; };

struct StaticOrder {
    int nM, nN, nwg, G, c;
    __host__ __device__ void init(int M, int N, int G_, int c_) { nM = M / BM; nN = N / BM; nwg = nM * nN; G = G_; c = c_; }
    __host__ __device__ bool next(int i, Unit& u) const {
        const long L = (long)i * G + c; if (L >= nwg) return false;
        int wgid = (int)L; { const int q = nwg / NXCD, r = nwg % NXCD, xcd = wgid % NXCD, off = wgid / NXCD; wgid = (xcd < r ? xcd * (q + 1) : r * (q + 1) + (xcd - r) * q) + off; }
        const int nig = WGM * nN, gid = wgid / nig, fm = gid * WGM, gsz = (nM - fm) < WGM ? (nM - fm) : WGM;
        u.pm = fm + ((wgid % nig) % gsz); u.pn = (wgid % nig) / gsz; u.ka = 0; u.kb = 0; u.ui = i; u.ks = 0; return true;
    }
    __device__ __forceinline__ void a_ready(const Unit&) const {}
    __device__ __forceinline__ void done(const Unit&) const {}
};
struct HeadOrder {
    int nM, nH, nwg, G, c, K;
    __host__ __device__ void init(int M, int nH_, int K_, int G_, int c_) { nM = M / BM; nH = nH_; nwg = nM * nH; G = G_; c = c_; K = K_; }
    __host__ __device__ bool next(int i, Unit& u) const {
        const long L = (long)i * G + c; if (L >= nwg) return false;
        u.pm = (int)(L % nM); u.pn = (int)(L / nM); u.ka = u.pn * K; u.kb = 0; u.ui = i; u.ks = 0; return true;
    }
    __device__ __forceinline__ void a_ready(const Unit&) const {}
    __device__ __forceinline__ void done(const Unit&) const {}
};

struct SplitOrder {
    int nN, S, Kc, nwg, G, c;
    __host__ __device__ void init(int nM, int nN_, int S_, int Kc_, int G_, int c_) { nN = nN_; S = S_; Kc = Kc_; nwg = nM * nN_ * S_; G = G_; c = c_; }
    __host__ __device__ bool next(int i, Unit& u) const {
        const long L = (long)i * G + c; if (L >= nwg) return false;
        const int per = S * nN, rem = (int)(L % per); u.pm = (int)(L / per); u.pn = rem / S; u.ks = rem % S; u.ka = u.ks * Kc; u.kb = u.ka; u.ui = i; return true;
    }
    __device__ __forceinline__ void a_ready(const Unit&) const {}
    __device__ __forceinline__ void done(const Unit&) const {}
};
__device__ __forceinline__ unsigned cvt_pk_bf16(float lo, float hi) { unsigned r; asm volatile("v_cvt_pk_bf16_f32 %0, %1, %2" : "=v"(r) : "v"(lo), "v"(hi)); return r; }

template <int ACT> struct EpiScale {
    static constexpr bool PERM = true, AFTER_DRAIN = false;
    bf16_t* O; int ldc; const PG8_LAS float* rs;
    __device__ __forceinline__ void operator()(const f32x4 (&acc)[2][2][4][2], const Unit& u, int wr, int wc, int fr, int fq) const {
        const int row0 = u.pm * BM + wr * 64 + fr, col0 = u.pn * BM + wc * 32 + 8 * fq;
        const PG8_LAS float* rt = rs + u.ui * 256 + wr * 64 + fr;
#pragma unroll
        for (int ai = 0; ai < 2; ++ai)
#pragma unroll
            for (int m = 0; m < 4; ++m) { bf16_t* rowp = O + (size_t)(row0 + ai * HALF + m * 16) * ldc + col0; const float s = rt[ai * HALF + m * 16];
#pragma unroll
                for (int bj = 0; bj < 2; ++bj) { f32x4 v0 = acc[ai][bj][m][0] * s, v1 = acc[ai][bj][m][1] * s;
                    if (ACT == 1) {
#pragma unroll
                        for (int e = 0; e < 4; ++e) { const float a = fmaxf(v0[e], 0.f), b = fmaxf(v1[e], 0.f); v0[e] = a * a; v1[e] = b * b; } }
                    u32x4 w; w.x = cvt_pk_bf16(v0[0], v0[1]); w.y = cvt_pk_bf16(v0[2], v0[3]); w.z = cvt_pk_bf16(v1[0], v1[1]); w.w = cvt_pk_bf16(v1[2], v1[3]);
                    *(u32x4*)(rowp + bj * HALF) = w; } }
    }
};
template <bool FINAL> struct EpiResid {
    static constexpr bool PERM = true, AFTER_DRAIN = false;
    const bf16_t* xb; bf16_t* xbo; float* out; float* ssq; int ldc;
    __device__ __forceinline__ void operator()(const f32x4 (&acc)[2][2][4][2], const Unit& u, int wr, int wc, int fr, int fq) const {
        const int col0 = u.pn * BM + wc * 32 + 8 * fq;
        u32x4 xin[2][4][2];
#pragma unroll
        for (int ai = 0; ai < 2; ++ai)
#pragma unroll
            for (int m = 0; m < 4; ++m)
#pragma unroll
                for (int bj = 0; bj < 2; ++bj) xin[ai][m][bj] = *(const u32x4*)(xb + (size_t)(u.pm * BM + ai * HALF + wr * 64 + m * 16 + fr) * ldc + col0 + bj * HALF);
#pragma unroll
        for (int ai = 0; ai < 2; ++ai)
#pragma unroll
            for (int m = 0; m < 4; ++m) { const int row = u.pm * BM + ai * HALF + wr * 64 + m * 16 + fr; float q = 0.f;
#pragma unroll
                for (int bj = 0; bj < 2; ++bj) { const size_t o = (size_t)row * ldc + col0 + bj * HALF;
                    const u32x4 xi = xin[ai][m][bj];
                    f32x4 v0 = acc[ai][bj][m][0], v1 = acc[ai][bj][m][1];
                    v0[0] += __builtin_bit_cast(float, xi.x << 16); v0[1] += __builtin_bit_cast(float, xi.x & 0xffff0000u); v0[2] += __builtin_bit_cast(float, xi.y << 16); v0[3] += __builtin_bit_cast(float, xi.y & 0xffff0000u);
                    v1[0] += __builtin_bit_cast(float, xi.z << 16); v1[1] += __builtin_bit_cast(float, xi.z & 0xffff0000u); v1[2] += __builtin_bit_cast(float, xi.w << 16); v1[3] += __builtin_bit_cast(float, xi.w & 0xffff0000u);
                    if (FINAL) { *(f32x4*)(out + o) = v0; *(f32x4*)(out + o + 4) = v1; }
                    else { u32x4 w; w.x = cvt_pk_bf16(v0[0], v0[1]); w.y = cvt_pk_bf16(v0[2], v0[3]); w.z = cvt_pk_bf16(v1[0], v1[1]); w.w = cvt_pk_bf16(v1[2], v1[3]); *(u32x4*)(xbo + o) = w;
                        q += ((v0[0] * v0[0] + v0[1] * v0[1]) + (v0[2] * v0[2] + v0[3] * v0[3])) + ((v1[0] * v1[0] + v1[1] * v1[1]) + (v1[2] * v1[2] + v1[3] * v1[3])); } }
                if (!FINAL) { q += __shfl_xor(q, 16); q += __shfl_xor(q, 32);
                    if (fq == 0) ssq[(size_t)row * 64 + u.pn * 4 + wc] = q; } }
    }
};
struct EpiPartial {
    static constexpr bool PERM = false, AFTER_DRAIN = false;
    float* P; int ldp, ncols, mrows; const PG8_LAS float* rs;
    __device__ __forceinline__ void operator()(const f32x4 (&acc)[2][2][4][2], const Unit& u, int wr, int wc, int fr, int fq) const {
        const int col0 = u.pn * BM + wc * 32 + 4 * fq; const PG8_LAS float* rt = rs + u.ui * 256 + wr * 64 + fr;
#pragma unroll
        for (int ai = 0; ai < 2; ++ai)
#pragma unroll
            for (int m = 0; m < 4; ++m) { const int row = u.pm * BM + ai * HALF + wr * 64 + m * 16 + fr; const float sc = rt[ai * HALF + m * 16];
                float* rp = P + ((size_t)u.ks * mrows + row) * ldp;
#pragma unroll
                for (int bj = 0; bj < 2; ++bj)
#pragma unroll
                    for (int n = 0; n < 2; ++n) { const int c = col0 + bj * HALF + 16 * n; if (c < ncols) *(f32x4*)(rp + c) = acc[ai][bj][m][n] * sc; } }
    }
};
struct EpiLora {
    static constexpr bool PERM = true, AFTER_DRAIN = false;
    bf16_t* O; int ldc; const float* bias; int kind;
    __device__ __forceinline__ void operator()(const f32x4 (&acc)[2][2][4][2], const Unit& u, int wr, int wc, int fr, int fq) const {
        const int col0 = u.pn * BM + wc * 32 + 8 * fq;
#pragma unroll
        for (int bj = 0; bj < 2; ++bj) { const int c = col0 + bj * HALF; f32x4 b0 = (f32x4){0.f, 0.f, 0.f, 0.f}, b1 = b0; if (kind != 2) { b0 = *(const f32x4*)(bias + c); b1 = *(const f32x4*)(bias + c + 4); }
#pragma unroll
            for (int ai = 0; ai < 2; ++ai)
#pragma unroll
                for (int m = 0; m < 4; ++m) { const int row = u.pm * BM + ai * HALF + wr * 64 + m * 16 + fr; f32x4 v0 = acc[ai][bj][m][0] + b0, v1 = acc[ai][bj][m][1] + b1;
                    if (kind == 0) {
#pragma unroll
                        for (int e = 0; e < 4; ++e) { float x = -v0[e]; float sp = fmaxf(x, 0.f) + 0.6931471805599453f * __builtin_amdgcn_logf(1.f + __builtin_amdgcn_exp2f(-1.4426950408889634f * fabsf(x))); v0[e] = -1.4426950408889634f * __builtin_amdgcn_exp2f(-1.4426950408889634f * (sp + 0.5f));
                            x = -v1[e]; sp = fmaxf(x, 0.f) + 0.6931471805599453f * __builtin_amdgcn_logf(1.f + __builtin_amdgcn_exp2f(-1.4426950408889634f * fabsf(x))); v1[e] = -1.4426950408889634f * __builtin_amdgcn_exp2f(-1.4426950408889634f * (sp + 0.5f)); } }
                    else if (kind == 1) {
#pragma unroll
                        for (int e = 0; e < 4; ++e) { v0[e] = __builtin_amdgcn_rcpf(1.f + __builtin_amdgcn_exp2f(-1.4426950408889634f * v0[e])); v1[e] = __builtin_amdgcn_rcpf(1.f + __builtin_amdgcn_exp2f(-1.4426950408889634f * v1[e])); } }
                    u32x4 w; w.x = cvt_pk_bf16(v0[0], v0[1]); w.y = cvt_pk_bf16(v0[2], v0[3]); w.z = cvt_pk_bf16(v1[0], v1[1]); w.w = cvt_pk_bf16(v1[2], v1[3]);
                    *(u32x4*)(O + (size_t)row * ldc + c) = w; } }
    }
};


template <class Epi, class Sched, bool ALIGN_EPI = false, bool SP2 = false>
__device__ __forceinline__ void gemm_phase(PG8_LAS unsigned char* lds, const Gemm g, const Sched& S, const Epi& E) {
    const int tid = threadIdx.x, wid = __builtin_amdgcn_readfirstlane(tid >> 6), lane = tid & 63, wr = wid >> 2, wc = wid & 3, fr = lane & 15, fq = lane >> 4;
    const int K = g.K, nt = K / BK, lda = g.lda, ldb = g.ldb;
    unsigned voffA[2], voffB[2];
#pragma unroll
    for (int i = 0; i < 2; ++i) { int R, C; stage_rc(tid * 16 + i * 8192, R, C); const int Rb = Epi::PERM ? ((R & ~31) + perm32(R & 31)) : R;
        voffA[i] = (unsigned)(R * lda + C) * 2u; voffB[i] = (unsigned)(Rb * ldb + C) * 2u; }
    const size_t kstep = (size_t)(BK * 2);
    const size_t hstepA = (size_t)HALF * lda * 2, hstepB = (size_t)HALF * ldb * 2;
    const size_t tstepA = 2 * hstepA, tstepB = 2 * hstepB;
    const unsigned ldsw = (unsigned)wid * 1024u;
    const int aoff = lds_byte(wr * 64 + fr, fq * 8), boff = lds_byte(wc * 32 + fr, fq * 8);
#define PG8_SA(b, h) (((b) * 2 + (h)) * HTB)
#define PG8_SB(b, h) ((4 + (b) * 2 + (h)) * HTB)
#define PG8_STAGE(bufoff, gbase, voff) do { _Pragma("unroll") for (int _i = 0; _i < 2; ++_i) \
        __builtin_amdgcn_global_load_lds((const unsigned*)((const char*)(gbase) + (voff)[_i]), (PG8_LAS unsigned*)(lds + (bufoff) + ldsw + _i * 8192), 16, 0, 0); } while (0)
#define PG8_LDA(dst, b, h) do { _Pragma("unroll") for (int m = 0; m < 4; ++m) _Pragma("unroll") for (int k = 0; k < 2; ++k) dst[m][k] = *(const PG8_LAS bf16x8*)(lds + PG8_SA(b, h) + aoff + m * 2048 + k * 1024); } while (0)
#define PG8_LDB(dst, b, h) do { _Pragma("unroll") for (int n = 0; n < 2; ++n) _Pragma("unroll") for (int k = 0; k < 2; ++k) dst[n][k] = *(const PG8_LAS bf16x8*)(lds + PG8_SB(b, h) + boff + n * 2048 + k * 1024); } while (0)
#define PG8_MMA(ai, bj, At, Bt) do { __builtin_amdgcn_s_setprio(1); _Pragma("unroll") for (int m = 0; m < 4; ++m) _Pragma("unroll") for (int n = 0; n < 2; ++n) _Pragma("unroll") for (int k = 0; k < 2; ++k) \
        acc[ai][bj][m][n] = __builtin_amdgcn_mfma_f32_16x16x32_bf16(Bt[n][k], At[m][k], acc[ai][bj][m][n], 0, 0, 0); __builtin_amdgcn_s_setprio(0); } while (0)
#define PG8_WAIT_V(n) asm volatile("s_waitcnt vmcnt(" #n ")" ::: "memory")
#define PG8_WAIT_L(n) asm volatile("s_waitcnt lgkmcnt(" #n ")" ::: "memory")
#define PG8_BAR __builtin_amdgcn_s_barrier()
#define PG8_SCHED __builtin_amdgcn_sched_barrier(0)
    Unit cur, nxt; int ui = 0;
    if (!S.next(0, cur)) return;
    f32x4 acc[2][2][4][2];
#pragma unroll
    for (int a = 0; a < 2; ++a)
#pragma unroll
        for (int b = 0; b < 2; ++b)
#pragma unroll
            for (int m = 0; m < 4; ++m)
#pragma unroll
                for (int n = 0; n < 2; ++n) acc[a][b][m][n] = (f32x4){0.f, 0.f, 0.f, 0.f};
    bf16x8 At[4][2], B0[2][2], B1[2][2];
    const char* cA = (const char*)g.A + (size_t)cur.pm * tstepA + (size_t)cur.ka * 2; const char* cB = (const char*)g.Bt + (size_t)cur.pn * tstepB + (size_t)cur.kb * 2;
    S.a_ready(cur);
    if constexpr (SP2) {
        PG8_STAGE(PG8_SB(0, 0), cB, voffB); PG8_STAGE(PG8_SB(0, 1), cB + hstepB, voffB); PG8_STAGE(PG8_SA(0, 0), cA, voffA); PG8_STAGE(PG8_SA(0, 1), cA + hstepA, voffA);
        if (wr == 1) PG8_BAR;
        PG8_WAIT_V(2); PG8_BAR;
        PG8_STAGE(PG8_SB(1, 0), cB + kstep, voffB); PG8_STAGE(PG8_SA(1, 0), cA + kstep, voffA); PG8_STAGE(PG8_SB(1, 1), cB + hstepB + kstep, voffB);
        PG8_WAIT_V(6); PG8_BAR;
    } else {
        PG8_STAGE(PG8_SB(0, 0), cB, voffB); PG8_STAGE(PG8_SA(0, 0), cA, voffA); PG8_STAGE(PG8_SB(0, 1), cB + hstepB, voffB); PG8_STAGE(PG8_SA(0, 1), cA + hstepA, voffA);
        if (wr == 1) PG8_BAR;
        PG8_WAIT_V(4); PG8_BAR;
        PG8_STAGE(PG8_SB(1, 0), cB + kstep, voffB); PG8_STAGE(PG8_SA(1, 0), cA + kstep, voffA); PG8_STAGE(PG8_SB(1, 1), cB + hstepB + kstep, voffB);
        PG8_WAIT_V(6); PG8_BAR;
    }
    for (;;) {
        const bool has_next = S.next(ui + 1, nxt);
        const char* nA = has_next ? (const char*)g.A + (size_t)nxt.pm * tstepA + (size_t)nxt.ka * 2 : cA; const char* nB = has_next ? (const char*)g.Bt + (size_t)nxt.pn * tstepB + (size_t)nxt.kb * 2 : cB;
        for (int t = 0; t < nt; t += 2) {
            const bool last = (t == nt - 2);
            const char* a1 = cA + (size_t)(t + 1) * kstep;
            const char* a2 = last ? nA : cA + (size_t)(t + 2) * kstep; const char* b2 = last ? nB : cB + (size_t)(t + 2) * kstep;
            const char* a3 = a2 + kstep; const char* b3 = b2 + kstep;
            if (last && has_next) S.a_ready(nxt);
            if constexpr (SP2) {
            PG8_LDB(B0, 0, 0); PG8_LDB(B1, 0, 1); PG8_SCHED; PG8_LDA(At, 0, 0); PG8_STAGE(PG8_SA(1, 1), a1 + hstepA, voffA);
            PG8_WAIT_V(8); PG8_WAIT_L(0); PG8_BAR; PG8_MMA(0, 0, At, B0); PG8_MMA(0, 1, At, B1); PG8_BAR; PG8_SCHED;
            PG8_LDA(At, 0, 1); PG8_STAGE(PG8_SB(0, 0), b2, voffB); PG8_STAGE(PG8_SB(0, 1), b2 + hstepB, voffB); PG8_STAGE(PG8_SA(0, 0), a2, voffA);
            PG8_WAIT_V(8); PG8_WAIT_L(0); PG8_BAR; PG8_MMA(1, 0, At, B0); PG8_MMA(1, 1, At, B1); PG8_BAR; PG8_SCHED;
            PG8_LDB(B0, 1, 0); PG8_LDB(B1, 1, 1); PG8_SCHED; PG8_LDA(At, 1, 0); PG8_STAGE(PG8_SA(0, 1), a2 + hstepA, voffA);
            PG8_WAIT_V(8); PG8_WAIT_L(0); PG8_BAR; PG8_MMA(0, 0, At, B0); PG8_MMA(0, 1, At, B1); PG8_BAR; PG8_SCHED;
            PG8_LDA(At, 1, 1); PG8_STAGE(PG8_SB(1, 0), b3, voffB); PG8_STAGE(PG8_SB(1, 1), b3 + hstepB, voffB); PG8_STAGE(PG8_SA(1, 0), a3, voffA);
            PG8_WAIT_V(8); PG8_WAIT_L(0); PG8_BAR; PG8_MMA(1, 0, At, B0); PG8_MMA(1, 1, At, B1); PG8_BAR; PG8_SCHED;
            } else {
            PG8_LDB(B0, 0, 0); PG8_SCHED; PG8_LDA(At, 0, 0); PG8_STAGE(PG8_SA(1, 1), a1 + hstepA, voffA);
            PG8_WAIT_L(8); PG8_BAR; PG8_WAIT_L(0); PG8_MMA(0, 0, At, B0); PG8_BAR; PG8_SCHED;
            PG8_LDB(B1, 0, 1); PG8_STAGE(PG8_SB(0, 0), b2, voffB);
            PG8_BAR; PG8_WAIT_L(0); PG8_MMA(0, 1, At, B1); PG8_BAR;
            PG8_LDA(At, 0, 1); PG8_STAGE(PG8_SA(0, 0), a2, voffA);
            PG8_BAR; PG8_WAIT_L(0); PG8_MMA(1, 0, At, B0); PG8_BAR; PG8_SCHED;
            PG8_STAGE(PG8_SB(0, 1), b2 + hstepB, voffB);
            PG8_WAIT_V(6); PG8_BAR; PG8_MMA(1, 1, At, B1); PG8_BAR;
            PG8_LDB(B0, 1, 0); PG8_SCHED; PG8_LDA(At, 1, 0); PG8_STAGE(PG8_SA(0, 1), a2 + hstepA, voffA);
            PG8_WAIT_L(8); PG8_BAR; PG8_WAIT_L(0); PG8_MMA(0, 0, At, B0); PG8_BAR; PG8_SCHED;
            PG8_LDB(B1, 1, 1); PG8_STAGE(PG8_SB(1, 0), b3, voffB);
            PG8_BAR; PG8_WAIT_L(0); PG8_MMA(0, 1, At, B1); PG8_BAR;
            PG8_LDA(At, 1, 1); PG8_STAGE(PG8_SA(1, 0), a3, voffA);
            PG8_BAR; PG8_WAIT_L(0); PG8_MMA(1, 0, At, B0); PG8_BAR; PG8_SCHED;
            PG8_STAGE(PG8_SB(1, 1), b3 + hstepB, voffB);
            PG8_WAIT_V(6); PG8_BAR; PG8_MMA(1, 1, At, B1); PG8_BAR;
            }
        }
        if constexpr (ALIGN_EPI) { if (wr == 0) PG8_BAR; }
        if constexpr (!Epi::AFTER_DRAIN) { E(acc, cur, wr, wc, fr, fq); S.done(cur); }
        if (!has_next) break;
#pragma unroll
        for (int a = 0; a < 2; ++a)
#pragma unroll
            for (int b = 0; b < 2; ++b)
#pragma unroll
                for (int m = 0; m < 4; ++m)
#pragma unroll
                    for (int n = 0; n < 2; ++n) acc[a][b][m][n] = (f32x4){0.f, 0.f, 0.f, 0.f};
        cur = nxt; cA = nA; cB = nB; ++ui;
        if constexpr (ALIGN_EPI) { if (wr == 1) PG8_BAR; }
    }
    PG8_WAIT_V(0);
    if constexpr (!ALIGN_EPI) { if (wr == 0) PG8_BAR; }
    PG8_BAR;
    if constexpr (Epi::AFTER_DRAIN) { E.fused(acc, cur, wr, wc, fr, fq, lds, wid, lane); S.done(cur); }
#undef PG8_SA
#undef PG8_SB
#undef PG8_STAGE
#undef PG8_LDA
#undef PG8_LDB
#undef PG8_MMA
#undef PG8_WAIT_V
#undef PG8_WAIT_L
#undef PG8_BAR
#undef PG8_SCHED
}
}

constexpr int NWAVES = 8, NTHR = 512, GRID = 256;
constexpr int D = 4096, SEQ = 2048, NB = 4, M = NB * SEQ, FF = 4 * D;
constexpr int HY_IN = 10688, LDZ0 = 10752;
constexpr int ML_IN = 12304, LDZ1 = 12544;
constexpr int ZC_R = 4096, ZC_K = 6144, ZC_V = 8192, ZC_WL = 10240, ZC_AL = 10336, ZC_GL = 10432;
constexpr int MC_Q = 0, MC_K = 2048, MC_V = 4096, MC_O = 8192, MC_I = 12288, MC_F = 12296;
constexpr float NORM_EPS = 1e-6f, GN_EPS = 64e-5f;
constexpr int N_PHASES = 15;

constexpr size_t MiB = 1u << 20;
constexpr size_t WS_CTL = 0, CTL_ZERO_BYTES = 1 * MiB;
constexpr size_t WS_WHYIN = 1 * MiB;
constexpr size_t WS_WHYOUT = WS_WHYIN + (size_t)LDZ0 * D * 2;
constexpr size_t WS_WUP = WS_WHYOUT + (size_t)D * D * 2;
constexpr size_t WS_WDOWN = WS_WUP + 2 * (size_t)FF * D * 2;
constexpr size_t WS_WMLIN = WS_WDOWN + 2 * (size_t)FF * D * 2;
constexpr size_t WS_WMLOUT = WS_WMLIN + (size_t)LDZ1 * D * 2;
constexpr size_t WS_W2T = WS_WMLOUT + (size_t)D * D * 2;
constexpr size_t WS_A2T = WS_W2T + 2048 * 128 * 2;
constexpr size_t WS_G2T = WS_A2T + 2048 * 128 * 2;
constexpr size_t WS_WAT = WS_G2T + 2048 * 256 * 2;
constexpr size_t WS_WXT = WS_WAT + 256 * 2048 * 2;
constexpr size_t WS_XB = WS_WXT + 256 * 2048 * 2;
constexpr size_t WS_XF = WS_XB + (size_t)M * D * 2;
constexpr size_t WS_CAT = WS_XF + (size_t)M * D * 4;
constexpr size_t WS_SSQ = WS_CAT + (size_t)M * D * 2;
constexpr size_t WS_U = WS_SSQ + (size_t)M * 64 * 4;
constexpr size_t WS_Z = WS_U;
constexpr size_t WS_DEC = WS_U + (size_t)M * FF * 2;
constexpr size_t WS_AA = WS_DEC + (size_t)M * 2048 * 4;
constexpr size_t WS_GG = WS_AA + (size_t)M * 2048 * 4;
constexpr size_t WS_AW = WS_GG + (size_t)M * 2048 * 4;
constexpr size_t WS_AAL = WS_AW + (size_t)M * 128 * 2;
constexpr size_t WS_AG = WS_AAL + (size_t)M * 128 * 2;
constexpr size_t WS_HRAW = WS_DEC;
constexpr size_t WS_HSSQ = WS_GG;
constexpr size_t WS_ZP = WS_AG + (size_t)M * 256 * 2;
constexpr size_t WS_END = WS_ZP + 8 * (size_t)M * 16 * 4;
static_assert((size_t)M * LDZ1 * 2 <= (size_t)M * FF * 2, "Z fits in U's region");
static_assert(WS_HRAW + (size_t)M * D * 4 <= WS_GG, "HRAW fits in DEC|AA");
constexpr int CW_BAR = 4096;

constexpr int RING_BYTES = 131072;
constexpr int RS_OFF = RING_BYTES, RS_BYTES = 8192;
constexpr int LDSCTL_OFF = RS_OFF + RS_BYTES, MISC_OFF = LDSCTL_OFF + 320;
constexpr int LDS_BYTES = 147456;
static_assert(MISC_OFF + 128 <= LDS_BYTES, "LDS map");

#define GAS __attribute__((address_space(1)))
#define LAS __attribute__((address_space(3)))
typedef unsigned short bf16;
typedef unsigned v4u __attribute__((ext_vector_type(4)));
typedef unsigned v2u __attribute__((ext_vector_type(2)));
typedef float f32x4 __attribute__((ext_vector_type(4)));
typedef float f32x2 __attribute__((ext_vector_type(2)));
typedef GAS unsigned gu32;
#define RLX_AGENT __ATOMIC_RELAXED, __HIP_MEMORY_SCOPE_AGENT
#define LDS_WAIT() asm volatile("s_waitcnt lgkmcnt(0)" ::: "memory")
#define VM_WAIT() asm volatile("s_waitcnt vmcnt(0)" ::: "memory")
typedef __bf16 hwbf2_t __attribute__((ext_vector_type(2)));
__device__ __forceinline__ unsigned pk2(float lo, float hi) { const f32x2 v = {lo, hi}; return __builtin_bit_cast(unsigned, __builtin_convertvector(v, hwbf2_t)); }
__device__ __forceinline__ unsigned f2bf(float f) { return (unsigned)__builtin_bit_cast(unsigned short, (__bf16)f); }
__device__ __forceinline__ float bflo(unsigned w) { return __builtin_bit_cast(float, w << 16); }
__device__ __forceinline__ float bfhi(unsigned w) { return __builtin_bit_cast(float, w & 0xffff0000u); }
__device__ __forceinline__ float bf2f(bf16 h) { return __builtin_bit_cast(float, (unsigned)h << 16); }
__device__ __forceinline__ float sigmoidf_(float x) { return 1.f / (1.f + expf(-x)); }
__device__ __forceinline__ float fexp2(float x) { return __builtin_amdgcn_exp2f(x); }
__device__ __forceinline__ float fexp(float x) { return __builtin_amdgcn_exp2f(x * 1.4426950408889634f); }
__device__ __forceinline__ float frcp(float x) { return __builtin_amdgcn_rcpf(x); }
__device__ __forceinline__ float fsigmoid(float x) { return __builtin_amdgcn_rcpf(1.f + __builtin_amdgcn_exp2f(-1.4426950408889634f * x)); }
__device__ __forceinline__ float ftanh(float x) { return 1.f - 2.f * __builtin_amdgcn_rcpf(1.f + __builtin_amdgcn_exp2f(2.8853900817779268f * x)); }
__device__ __forceinline__ float flogsig(float x) {
    const float e = fexp2(-1.4426950408889634f * fabsf(x)), u = 1.f + e, d = u - 1.f;
    const float l = (d == 0.f) ? e : 0.6931471805599453f * __builtin_amdgcn_logf(u) * (e * frcp(d));
    return fminf(x, 0.f) - l;
}
template <int CTRL, int RM> __device__ __forceinline__ float dpp_id(float idv, float v) { return __builtin_bit_cast(float, __builtin_amdgcn_update_dpp(__builtin_bit_cast(int, idv), __builtin_bit_cast(int, v), CTRL, RM, 0xF, false)); }
__device__ __forceinline__ float scan_add64(float v) {
    v += dpp_id<0x111, 0xF>(0.f, v); v += dpp_id<0x112, 0xF>(0.f, v); v += dpp_id<0x114, 0xF>(0.f, v); v += dpp_id<0x118, 0xF>(0.f, v);
    v += dpp_id<0x142, 0xA>(0.f, v); v += dpp_id<0x143, 0xC>(0.f, v); return v; }
__device__ __forceinline__ float scan_max64(float v) { const float ni = -3.0e38f;
    v = fmaxf(v, dpp_id<0x111, 0xF>(ni, v)); v = fmaxf(v, dpp_id<0x112, 0xF>(ni, v)); v = fmaxf(v, dpp_id<0x114, 0xF>(ni, v)); v = fmaxf(v, dpp_id<0x118, 0xF>(ni, v));
    v = fmaxf(v, dpp_id<0x142, 0xA>(ni, v)); v = fmaxf(v, dpp_id<0x143, 0xC>(ni, v)); return v; }
__device__ __forceinline__ float lane63(float v) { return __builtin_bit_cast(float, __builtin_amdgcn_readlane(__builtin_bit_cast(int, v), 63)); }
__device__ __forceinline__ float fgelu_tanh(float x) { return 0.5f * x * (1.f + ftanh(0.7978845608028654f * (x + 0.044715f * x * x * x))); }
__device__ __forceinline__ float softplusf_(float x) { return fmaxf(x, 0.f) + log1pf(expf(-fabsf(x))); }
__device__ __forceinline__ float gelu_tanh(float x) { return 0.5f * x * (1.f + tanhf(0.7978845608028654f * (x + 0.044715f * x * x * x))); }
template <int CTRL> __device__ __forceinline__ float dpp_f(float v) { return __builtin_bit_cast(float, __builtin_amdgcn_update_dpp(0, __builtin_bit_cast(int, v), CTRL, 0xF, 0xF, false)); }
__device__ __forceinline__ float red4(float v) { v += dpp_f<0xB1>(v); v += dpp_f<0x4E>(v); return v; }
__device__ __forceinline__ float red8(float v) { v = red4(v); v += dpp_f<0x141>(v); return v; }
__device__ __forceinline__ float red16(float v) { v = red8(v); v += dpp_f<0x140>(v); return v; }


#define XB_TMO      128
#define XB_XCNT(j)  (256  + 64 * (j))
#define XB_XSUB(j)  (1280 + 64 * (j))
#define XB_XGEN(j)  (2304 + 64 * (j))
#define XB_TOP      3328
#define XB_TOPGEN   3392
#define XCD_BAR_WORDS 3456
#define XB_SPIN_CAP (1u << 18)

__device__ __forceinline__ unsigned xb_ld(unsigned* p)              { return __hip_atomic_load(p, __ATOMIC_RELAXED, __HIP_MEMORY_SCOPE_AGENT); }
__device__ __forceinline__ unsigned xb_add(unsigned* p, unsigned v) { return __hip_atomic_fetch_add(p, v, __ATOMIC_RELAXED, __HIP_MEMORY_SCOPE_AGENT); }
__device__ __forceinline__ unsigned xb_xcc_id() { return (unsigned)__builtin_amdgcn_s_getreg((3 << 11) | 20) & 0xFu; }
#define XB_SPIN(cond, bar) do { unsigned _sp = 0; while (cond) { __builtin_amdgcn_s_sleep(1); \
    if ((++_sp & 255u) == 0u) { if (xb_ld(&(bar)[XB_TMO])) break; if (_sp > XB_SPIN_CAP) { atomicAdd(&(bar)[XB_TMO], 1u); break; } } } } while (0)

struct XcdBarrier {
    unsigned* bar; unsigned x;
    volatile LAS unsigned* st;
};

__device__ __forceinline__ XcdBarrier xcd_barrier_post(unsigned* bar, volatile LAS unsigned* st) {
    XcdBarrier b; b.bar = bar; b.x = xb_xcc_id(); b.st = st;
    if (threadIdx.x == 0) (void)xb_add(&bar[XB_XCNT(b.x)], 1u);
    return b;
}
__device__ __forceinline__ void xcd_barrier_complete(unsigned* bar, unsigned x, unsigned& nloc, unsigned& nx) {
    const unsigned G = gridDim.x * gridDim.y * gridDim.z;
    unsigned sum, cnt, mine, sp = 0u;
    for (;;) {
        sum = 0u; cnt = 0u; mine = 0u;
#pragma unroll
        for (unsigned j = 0; j < 16; ++j) { const unsigned c = xb_ld(&bar[XB_XCNT(j)]); sum += c; cnt += (c > 0u) ? 1u : 0u; mine = (j == x) ? c : mine; }
        if (sum == G) break;
        __builtin_amdgcn_s_sleep(1);
        if ((++sp & 255u) == 0u) { if (xb_ld(&bar[XB_TMO])) break; if (sp > XB_SPIN_CAP) { atomicAdd(&bar[XB_TMO], 1u); break; } }
    }
    nloc = mine > 0u ? mine : 1u; nx = cnt > 0u ? cnt : 1u;
}

__device__ __forceinline__ void xcd_barrier(const XcdBarrier& b) {
    asm volatile("s_waitcnt vmcnt(0)" ::: "memory");
    __syncthreads();
    if (threadIdx.x == 0) {
        unsigned* bar = b.bar;
        __builtin_amdgcn_s_waitcnt(0);
        unsigned nloc = b.st[0], nx = b.st[1];
        if (nloc == 0u) { xcd_barrier_complete(bar, b.x, nloc, nx); b.st[0] = nloc; b.st[1] = nx; }
        const unsigned old = xb_add(&bar[XB_XSUB(b.x)], 1u);
        const unsigned gen = old / nloc;
        if (old + 1u == (gen + 1u) * nloc) {
            __builtin_amdgcn_fence(__ATOMIC_RELEASE, "agent");
            asm volatile("s_waitcnt vmcnt(0)" ::: "memory");
            const unsigned og = xb_add(&bar[XB_TOP], 1u);
            const unsigned tg = og / nx;
            if (og + 1u == (tg + 1u) * nx) xb_add(&bar[XB_TOPGEN], 1u);
            else XB_SPIN(xb_ld(&bar[XB_TOPGEN]) == tg, bar);
            __builtin_amdgcn_fence(__ATOMIC_ACQUIRE, "agent");
            xb_add(&bar[XB_XGEN(b.x)], 1u);
            asm volatile("s_waitcnt vmcnt(0)" ::: "memory");
        } else {
            XB_SPIN(xb_ld(&bar[XB_XGEN(b.x)]) == gen, bar);
            __builtin_amdgcn_fence(__ATOMIC_ACQUIRE, "agent");
            asm volatile("s_waitcnt vmcnt(0)" ::: "memory");
        }
    }
    __syncthreads();
}


struct Args { const float* in[31]; float* out; unsigned char* ws; int ph_lo, ph_hi; };
#define CAS __attribute__((address_space(4)))
enum { I_X = 0, I_NMIX, I_NMLP, I_NFIN, I_UP, I_DOWN, I_HYIN, I_CONVW, I_CONVB, I_WA, I_BA, I_WX, I_BX, I_LAM, I_MU, I_W0, I_W2, I_A0, I_A2, I_G2, I_KK, I_KA, I_RK,
       I_LNW, I_LNB, I_HYOUT, I_MLIN, I_BI, I_BF, I_MLNORM, I_MLOUT };

__device__ __forceinline__ float wave_sum(float v) {
#pragma unroll
    for (int o = 1; o < 64; o <<= 1) v += __shfl_xor(v, o);
    return v;
}

__device__ __forceinline__ void conv_item(const float* W, int K, int N, bf16* WT, int ldk, const float* gain, LAS float* scr, int kt, int ntile, int lane) {
    const int k0 = kt * 64, n0 = ntile * 64, nl = (lane & 15) * 4, n = n0 + nl;
    f32x4 v[16]; float gv[16];
#pragma unroll
    for (int i = 0; i < 16; ++i) { const int k = k0 + i * 4 + (lane >> 4); v[i] = (f32x4){0.f, 0.f, 0.f, 0.f}; gv[i] = 1.f;
        if (k < K && n < N) { v[i] = __builtin_nontemporal_load((const f32x4*)(W + (size_t)k * N + n)); if (gain) gv[i] = gain[k]; } }
#pragma unroll
    for (int i = 0; i < 16; ++i) { const int kl = i * 4 + (lane >> 4); const f32x4 x = v[i] * gv[i];
        LAS float* s = scr + kl * 65 + nl; s[0] = x.x; s[1] = x.y; s[2] = x.z; s[3] = x.w; }
    LDS_WAIT(); asm volatile("" ::: "memory");
    const int c = lane & 7;
#pragma unroll
    for (int j = 0; j < 8; ++j) { const int r = j * 8 + (lane >> 3); const LAS float* s = scr + (8 * c) * 65 + r;
        v4u o; o.x = pk2(s[0], s[65]); o.y = pk2(s[130], s[195]); o.z = pk2(s[260], s[325]); o.w = pk2(s[390], s[455]);
        *(GAS v4u*)(WT + (size_t)(n0 + r) * ldk + k0 + 8 * c) = o; }
    LDS_WAIT(); asm volatile("" ::: "memory");
}
constexpr int CONV_TOTAL = 32 * 2 + 32 * 2 + 32 * 4 + 2 * 4 * 32 + (LDZ0 / 64) * 64 + 64 * 64 + (FF / 64) * 64 + 64 * (FF / 64) + (LDZ1 / 64) * 64 + 64 * 64 + 64 * (FF / 64) + (FF / 64) * 64;
constexpr int CONV_P9 = 36864, CONV_P4 = 16384;
constexpr int G1_WGS = 224;
constexpr int CONV_P1 = 26624;
constexpr int CONV_A = CONV_TOTAL - CONV_P9 - CONV_P4, CONV_B = CONV_TOTAL - CONV_P9, CONV_A0 = CONV_A - CONV_P1;
static_assert(CONV_A0 >= 32 * 2 + 32 * 2 + 32 * 4 + 2 * 4 * 32 + (LDZ0 / 64) * 64, "the layer-0 projection weights are converted in the prologue");
static_assert(CONV_P9 <= 2 * 64 * (FF / 64) + 64 * 64 && CONV_P9 + CONV_P4 <= 3 * 64 * (FF / 64) + 64 * 64, "deferred ranges: mLSTM-phase items are layer-1 output / MLP weights; RG-LRU-phase items are needed after phase 4 (layer-0 down, layer-1 weights)");
__device__ __forceinline__ void conv_range(LAS unsigned char* lds, const CAS Args* a, int first, int last, int gw, int ngw, int wave, int lane) {
    unsigned char* ws = a->ws;
    LAS float* scr = (LAS float*)(lds + wave * 16640);
#define CONV(Wp, K_, N_, NPAD_, WTp, LDK_, GAIN_) { constexpr int ntn = (NPAD_) / 64, cnt = ntn * ((LDK_) / 64); \
        if (r < cnt) { conv_item(Wp, K_, N_, (bf16*)(WTp), LDK_, GAIN_, scr, r / ntn, r % ntn, lane); continue; } r -= cnt; }
    for (int it = first + gw; it < last; it += ngw) {
        int r = it;
        CONV(a->in[I_W2], 96, 2048, 2048, ws + WS_W2T, 128, (const float*)nullptr)
        CONV(a->in[I_A2], 96, 2048, 2048, ws + WS_A2T, 128, (const float*)nullptr)
        CONV(a->in[I_G2], 256, 2048, 2048, ws + WS_G2T, 256, (const float*)nullptr)
        CONV(a->in[I_WA], 2048, 256, 256, ws + WS_WAT, 2048, (const float*)nullptr)
        CONV(a->in[I_WX], 2048, 256, 256, ws + WS_WXT, 2048, (const float*)nullptr)
        CONV(a->in[I_HYIN], D, HY_IN, LDZ0, ws + WS_WHYIN, D, a->in[I_NMIX])
        CONV(a->in[I_HYOUT], D, D, D, ws + WS_WHYOUT, D, (const float*)nullptr)
        CONV(a->in[I_UP], D, FF, FF, ws + WS_WUP, D, a->in[I_NMLP])
        CONV(a->in[I_MLIN], D, ML_IN, LDZ1, ws + WS_WMLIN, D, a->in[I_NMIX] + D)
        CONV(a->in[I_DOWN], FF, D, D, ws + WS_WDOWN, FF, (const float*)nullptr)
        CONV(a->in[I_MLOUT], D, D, D, ws + WS_WMLOUT, D, (const float*)nullptr)
        CONV(a->in[I_DOWN] + (size_t)D * FF, FF, D, D, ws + WS_WDOWN + (size_t)FF * D * 2, FF, (const float*)nullptr)
        CONV(a->in[I_UP] + (size_t)D * FF, D, FF, FF, ws + WS_WUP + (size_t)FF * D * 2, D, a->in[I_NMLP] + D)
    }
#undef CONV
}
constexpr int CQ_BATCH = 64, CW_QUEUE = 16384;
__device__ __forceinline__ void conv_queue(LAS unsigned char* lds, const CAS Args* a, int first, int last, int q, int tid) {
    volatile LAS int* slot = (volatile LAS int*)(lds + MISC_OFF + 64);
    unsigned* ctr = (unsigned*)(a->ws + WS_CTL) + CW_QUEUE + 64 * q;
    const int wave = __builtin_amdgcn_readfirstlane(tid >> 6), lane = tid & 63;
    unsigned nxt = 0u;
    if (tid == 0) nxt = __hip_atomic_fetch_add(ctr, (unsigned)CQ_BATCH, __ATOMIC_RELAXED, __HIP_MEMORY_SCOPE_AGENT);
    __syncthreads();
    for (int it = 0;; ++it) {
        if (tid == 0) { slot[it & 1] = (int)nxt; nxt = __hip_atomic_fetch_add(ctr, (unsigned)CQ_BATCH, __ATOMIC_RELAXED, __HIP_MEMORY_SCOPE_AGENT); }
        LDS_WAIT(); __syncthreads();
        const int base = first + slot[it & 1];
        if (base >= last) break;
        conv_range(lds, a, base, (base + CQ_BATCH < last) ? base + CQ_BATCH : last, wave, NWAVES, wave, lane);
    }
}
__device__ __forceinline__ void p0_prologue(LAS unsigned char* lds, const CAS Args* a, int vcu, int wave, int lane) {
    unsigned char* ws = a->ws;
    const int gw = vcu * NWAVES + wave, NGW = GRID * NWAVES;
    conv_range(lds, a, 0, CONV_A0, gw, NGW, wave, lane);
    const float* x = a->in[I_X]; bf16* XB = (bf16*)(ws + WS_XB); float* SSQ = (float*)(ws + WS_SSQ);
    for (int m = gw; m < M; m += NGW) {
        const GAS f32x4* xr = (const GAS f32x4*)(x + (size_t)m * D) + lane; GAS v2u* o = (GAS v2u*)(XB + (size_t)m * D) + lane; float s = 0.f;
#pragma unroll
        for (int j = 0; j < 16; ++j) { const f32x4 v = xr[64 * j]; s += (v.x * v.x + v.y * v.y) + (v.z * v.z + v.w * v.w); v2u w; w.x = pk2(v.x, v.y); w.y = pk2(v.z, v.w); o[64 * j] = w; }
        s = wave_sum(s); if (lane == 0) SSQ[(size_t)m * 64] = s;
    }
}

template <class Sched> __device__ __forceinline__ void build_rs(LAS float* tab, const Sched& S, const float* ssq, int npart, int tid) {
    pg8::Unit u; int prev_pm = -1;
    for (int i = 0; i < 8 && S.next(i, u); ++i) {
        if (u.pm == prev_pm) { if ((tid & 1) == 0) tab[i * 256 + (tid >> 1)] = tab[(i - 1) * 256 + (tid >> 1)]; continue; }
        prev_pm = u.pm;
        const int row = u.pm * 256 + (tid >> 1), half = tid & 1; float s = 0.f;
        if (npart == 64) { const GAS f32x4* p = (const GAS f32x4*)(ssq + (size_t)row * 64 + half * 32);
#pragma unroll
            for (int k = 0; k < 8; ++k) { const f32x4 v = p[k]; s += (v.x + v.y) + (v.z + v.w); } }
        else if (half == 0) s = ((const GAS float*)ssq)[(size_t)row * 64];
        s += __shfl_xor(s, 1);
        if (half == 0) tab[i * 256 + (tid >> 1)] = 1.0f / sqrtf(s * (1.0f / D) + NORM_EPS);
    }
    LDS_WAIT(); __syncthreads();
}

typedef short s16x8_t __attribute__((ext_vector_type(8)));
typedef short s16x4_t __attribute__((ext_vector_type(4)));
#define MFMA16(a_, b_, c_) __builtin_amdgcn_mfma_f32_16x16x32_bf16(a_, b_, c_, 0, 0, 0)
__device__ __forceinline__ s16x4_t lds_tr4(const LAS bf16* p) { return __builtin_bit_cast(s16x4_t, __builtin_amdgcn_ds_read_tr16_b64_v4i16((LAS s16x4_t*)p)); }
__device__ __forceinline__ s16x8_t cat4(s16x4_t x, s16x4_t y) { return (s16x8_t){x[0], x[1], x[2], x[3], y[0], y[1], y[2], y[3]}; }
__device__ __forceinline__ void rwkv_prepass(const CAS Args* a, int gtid) {
    const bf16* Z = (const bf16*)(a->ws + WS_Z); bf16* AW = (bf16*)(a->ws + WS_AW); bf16* AAL = (bf16*)(a->ws + WS_AAL); bf16* AG = (bf16*)(a->ws + WS_AG);
    const float* mu = a->in[I_MU];
    static_assert(M * 64 == 4 * GRID * NTHR, "prepass: four tokens per thread");
    const int cg = gtid & 63, t0 = gtid >> 6;
    if (cg >= 56) { const int p = cg - 56;
#pragma unroll
        for (int k = 0; k < 4; ++k) { bf16* dst = (p < 4 ? AW : AAL) + (size_t)(t0 + 2048 * k) * 128 + 96 + (p & 3) * 8; *(GAS v4u*)dst = (v4u){0u, 0u, 0u, 0u}; } }
    else {
        const float* mp = mu + (ZC_WL - ZC_R) + cg * 8; const f32x4 m0 = *(const GAS f32x4*)mp, m1 = *(const GAS f32x4*)(mp + 4);
        const float mu8[8] = {m0[0], m0[1], m0[2], m0[3], m1[0], m1[1], m1[2], m1[3]};
        v4u zc[4], zp[4];
#pragma unroll
        for (int k = 0; k < 4; ++k) { const int t = t0 + 2048 * k; const bf16* zr = Z + (size_t)t * LDZ0 + ZC_WL + cg * 8;
            zc[k] = *(const GAS v4u*)zr; zp[k] = (v4u){0u, 0u, 0u, 0u}; if ((t & (SEQ - 1)) != 0) zp[k] = *(const GAS v4u*)(zr - LDZ0); }
#pragma unroll
        for (int k = 0; k < 4; ++k) { const int t = t0 + 2048 * k; float v[8];
#pragma unroll
            for (int e = 0; e < 4; ++e) { const float c0 = bflo(zc[k][e]), c1 = bfhi(zc[k][e]), p0 = bflo(zp[k][e]), p1 = bfhi(zp[k][e]);
                v[2 * e] = c0 + (p0 - c0) * mu8[2 * e]; v[2 * e + 1] = c1 + (p1 - c1) * mu8[2 * e + 1]; }
            bf16* dst;
            if (cg < 12) { dst = AW + (size_t)t * 128 + cg * 8;
#pragma unroll
                for (int e = 0; e < 8; ++e) v[e] = ftanh(v[e]); }
            else if (cg < 24) { dst = AAL + (size_t)t * 128 + (cg - 12) * 8; }
            else { dst = AG + (size_t)t * 256 + (cg - 24) * 8;
#pragma unroll
                for (int e = 0; e < 8; ++e) v[e] = fsigmoid(v[e]); }
            v4u o; o.x = pk2(v[0], v[1]); o.y = pk2(v[2], v[3]); o.z = pk2(v[4], v[5]); o.w = pk2(v[6], v[7]);
            *(GAS v4u*)dst = o; }
    }
}

struct RwkvRaw { v4u zr, zrp, zk, zkp, zv, zvp, d, a, g; };
__device__ __forceinline__ void rwkv_load(RwkvRaw& R, const bf16* Z, const bf16* DEC, const bf16* AAp, const bf16* GG, int b, int h, int j, int ltt, int lcc) {
    const int tpos = j * 64 + ltt; const size_t g = (size_t)b * SEQ + tpos; const int c0 = h * 64 + lcc * 8;
    const bf16* zrow = Z + g * LDZ0 + c0;
    R.zr = *(const GAS v4u*)(zrow + ZC_R); R.zk = *(const GAS v4u*)(zrow + ZC_K); R.zv = *(const GAS v4u*)(zrow + ZC_V);
    if (tpos > 0) { R.zrp = *(const GAS v4u*)(zrow + ZC_R - LDZ0); R.zkp = *(const GAS v4u*)(zrow + ZC_K - LDZ0); R.zvp = *(const GAS v4u*)(zrow + ZC_V - LDZ0); }
    else { R.zrp = (v4u){0u, 0u, 0u, 0u}; R.zkp = R.zrp; R.zvp = R.zrp; }
    R.d = *(const GAS v4u*)(DEC + g * 2048 + c0); R.a = *(const GAS v4u*)(AAp + g * 2048 + c0); R.g = *(const GAS v4u*)(GG + g * 2048 + c0);
}
constexpr int RW_TS = 72;
__device__ __forceinline__ v4u pack8(const float (&x)[8]) { v4u o; o.x = pk2(x[0], x[1]); o.y = pk2(x[2], x[3]); o.z = pk2(x[4], x[5]); o.w = pk2(x[6], x[7]); return o; }
__device__ __forceinline__ void rwkv_phase(LAS unsigned char* lds, const CAS Args* a, int bh, int tid) {
    LAS bf16* KAP = (LAS bf16*)lds; LAS bf16* RHAT = KAP + 64 * RW_TS; LAS bf16* KHAT = RHAT + 64 * RW_TS; LAS bf16* AHAT = KHAT + 64 * RW_TS; LAS bf16* VB = AHAT + 64 * RW_TS;
    LAS float* LW = (LAS float*)(VB + 64 * RW_TS);
    LAS float* YY = LW + 4096;
    LAS float* LA = YY + 4096;
    LAS bf16* LK = (LAS bf16*)(LA + 1024);
    LAS bf16* UINV = LK + 1024; LAS bf16* G3M = UINV + 1024; LAS bf16* G4M = G3M + 1024;
    LAS float* GT = (LAS float*)(G4M + 1024);
    LAS float* BD = GT + 256;
    LAS float* PRM = BD + 64;
    const bf16* Z = (const bf16*)(a->ws + WS_Z); const bf16* DEC = (const bf16*)(a->ws + WS_DEC); const bf16* AAp = (const bf16*)(a->ws + WS_AA); const bf16* GG = (const bf16*)(a->ws + WS_GG);
    bf16* CAT = (bf16*)(a->ws + WS_CAT);
    const float* mu = a->in[I_MU]; const float* k_k = a->in[I_KK]; const float* k_a = a->in[I_KA]; const float* r_k = a->in[I_RK]; const float* ln_w = a->in[I_LNW]; const float* ln_b = a->in[I_LNB];
    const int b = bh >> 5, h = bh & 31, lane = tid & 63, wave = __builtin_amdgcn_readfirstlane(tid >> 6);
    const int ltt = tid >> 3, lcc = tid & 7, c0 = h * 64 + lcc * 8;
    const int i = lane & 15, g = lane >> 4, q4 = i >> 2, p4 = i & 3;
    const s16x4_t z4 = (s16x4_t){0, 0, 0, 0};
    f32x4 X[4];
#pragma unroll
    for (int t = 0; t < 4; ++t) X[t] = (f32x4){0.f, 0.f, 0.f, 0.f};
    RwkvRaw R; rwkv_load(R, Z, DEC, AAp, GG, b, h, 0, ltt, lcc);
    { const int p = tid >> 6, cc = h * 64 + (tid & 63);
      PRM[tid] = (p < 3) ? mu[p * 2048 + cc] : (p == 3) ? k_k[cc] : (p == 4) ? k_a[cc] : (p == 5) ? r_k[cc] : (p == 6) ? ln_w[cc] : ln_b[cc]; }
    LDS_WAIT(); __syncthreads();
    for (int j = 0; j < SEQ / 64; ++j) {
        const v4u gk = R.g;
        float rs[8], kkr[8], kt[8], ka[8], vs[8], lwv[8];
        {
            float ks[8], av[8], mur[8], muk[8], muv[8], pkk[8], pka[8], prk[8];
#pragma unroll
            for (int x = 0; x < 8; x += 4) { const LAS float* pp = PRM + lcc * 8 + x;
                const f32x4 a0 = *(const LAS f32x4*)pp, a1 = *(const LAS f32x4*)(pp + 64), a2 = *(const LAS f32x4*)(pp + 128), a3 = *(const LAS f32x4*)(pp + 192), a4 = *(const LAS f32x4*)(pp + 256), a5 = *(const LAS f32x4*)(pp + 320);
#pragma unroll
                for (int y = 0; y < 4; ++y) { mur[x + y] = a0[y]; muk[x + y] = a1[y]; muv[x + y] = a2[y]; pkk[x + y] = a3[y]; pka[x + y] = a4[y]; prk[x + y] = a5[y]; } }
#pragma unroll
            for (int e = 0; e < 4; ++e) {
                float c, p;
                c = bflo(R.zr[e]); p = bflo(R.zrp[e]); rs[2 * e] = c + (p - c) * mur[2 * e];
                c = bfhi(R.zr[e]); p = bfhi(R.zrp[e]); rs[2 * e + 1] = c + (p - c) * mur[2 * e + 1];
                c = bflo(R.zk[e]); p = bflo(R.zkp[e]); ks[2 * e] = c + (p - c) * muk[2 * e];
                c = bfhi(R.zk[e]); p = bfhi(R.zkp[e]); ks[2 * e + 1] = c + (p - c) * muk[2 * e + 1];
                c = bflo(R.zv[e]); p = bflo(R.zvp[e]); vs[2 * e] = c + (p - c) * muv[2 * e];
                c = bfhi(R.zv[e]); p = bfhi(R.zvp[e]); vs[2 * e + 1] = c + (p - c) * muv[2 * e + 1];
            }
#pragma unroll
            for (int e = 0; e < 4; ++e) { av[2 * e] = bflo(R.a[e]); av[2 * e + 1] = bfhi(R.a[e]); lwv[2 * e] = bflo(R.d[e]); lwv[2 * e + 1] = bfhi(R.d[e]); }
            float q = 0.f;
#pragma unroll
            for (int e = 0; e < 8; ++e) { kkr[e] = ks[e] * pkk[e]; q += kkr[e] * kkr[e]; }
            q = red8(q);
            const float inv = 1.0f / fmaxf(sqrtf(q), 1e-12f);
            float bd = 0.f;
#pragma unroll
            for (int e = 0; e < 8; ++e) { kkr[e] *= inv; kt[e] = ks[e] * (1.f + (av[e] - 1.f) * pka[e]); ka[e] = kkr[e] * av[e]; bd += rs[e] * kt[e] * prk[e]; }
            bd = red8(bd);
            *(LAS f32x4*)(LW + ltt * 64 + lcc * 8) = (f32x4){lwv[0], lwv[1], lwv[2], lwv[3]}; *(LAS f32x4*)(LW + ltt * 64 + lcc * 8 + 4) = (f32x4){lwv[4], lwv[5], lwv[6], lwv[7]};
            if (lcc == 0) BD[ltt] = bd;
        }
        LDS_WAIT(); __syncthreads();
        if (j + 1 < SEQ / 64) rwkv_load(R, Z, DEC, AAp, GG, b, h, j + 1, ltt, lcc);
        if (tid < 256) { LAS float* p = LW + (tid >> 6) * 1024 + (tid & 63); float x[16], acc = 0.f;
#pragma unroll
            for (int s = 0; s < 16; ++s) x[s] = p[s * 64];
#pragma unroll
            for (int s = 0; s < 16; ++s) { p[s * 64] = acc; acc += x[s]; } }
        LDS_WAIT(); __syncthreads();
        {
            const int sc = ltt >> 4, tl = ltt & 15;
            const f32x4 l0 = *(const LAS f32x4*)(LW + ltt * 64 + lcc * 8), l1 = *(const LAS f32x4*)(LW + ltt * 64 + lcc * 8 + 4);
            const float lgm[8] = {l0[0], l0[1], l0[2], l0[3], l1[0], l1[1], l1[2], l1[3]};
            float o0[8], o1[8], o2[8], o3[8], egl[8];
#pragma unroll
            for (int e = 0; e < 8; ++e) { const float em = fexp2(lgm[e]), el = em * fexp2(lwv[e]), iv = frcp(el);
                o0[e] = kkr[e] * em; o1[e] = rs[e] * el; o2[e] = kt[e] * iv; o3[e] = ka[e] * iv; egl[e] = el; }
            const int o = ltt * RW_TS + lcc * 8;
            *(LAS v4u*)(KAP + o) = pack8(o0); *(LAS v4u*)(RHAT + o) = pack8(o1); *(LAS v4u*)(KHAT + o) = pack8(o2); *(LAS v4u*)(AHAT + o) = pack8(o3); *(LAS v4u*)(VB + o) = pack8(vs);
            if (tl == 15) { *(LAS f32x4*)(GT + sc * 64 + lcc * 8) = (f32x4){egl[0], egl[1], egl[2], egl[3]}; *(LAS f32x4*)(GT + sc * 64 + lcc * 8 + 4) = (f32x4){egl[4], egl[5], egl[6], egl[7]}; }
        }
        LDS_WAIT(); __syncthreads();
        if (wave < 4) {
            const int sc = wave; const LAS bf16* kap = KAP + 16 * sc * RW_TS + i * RW_TS + 8 * g; const LAS bf16* rha = RHAT + 16 * sc * RW_TS + i * RW_TS + 8 * g;
            const LAS bf16* kha = KHAT + 16 * sc * RW_TS + i * RW_TS + 8 * g; const LAS bf16* aha = AHAT + 16 * sc * RW_TS + i * RW_TS + 8 * g;
            f32x4 g1 = (f32x4){0.f, 0.f, 0.f, 0.f}, g2 = g1, g3 = g1, g4 = g1;
#pragma unroll
            for (int ks = 0; ks < 2; ++ks) { const s16x8_t fa = *(const LAS s16x8_t*)(kap + 32 * ks), fr = *(const LAS s16x8_t*)(rha + 32 * ks), fk = *(const LAS s16x8_t*)(kha + 32 * ks), fh = *(const LAS s16x8_t*)(aha + 32 * ks);
                g1 = MFMA16(fa, fh, g1); g2 = MFMA16(fa, fk, g2); g3 = MFMA16(fr, fk, g3); g4 = MFMA16(fr, fh, g4); }
            { f32x4 lt4;
#pragma unroll
              for (int r = 0; r < 4; ++r) { const int t = 4 * g + r, o = sc * 256 + t * 16 + i; const bool lo = i < t, le = i <= t;
                lt4[r] = lo ? g1[r] : 0.f; LK[o] = (bf16)f2bf(lo ? g2[r] : 0.f); G3M[o] = (bf16)f2bf(le ? g3[r] : 0.f); G4M[o] = (bf16)f2bf(le ? g4[r] : 0.f); }
              *(LAS f32x4*)(LA + sc * 256 + i * 16 + 4 * g) = lt4; }
            LDS_WAIT(); asm volatile("" ::: "memory");
            float x[16];
#pragma unroll
            for (int t = 0; t < 16; ++t) x[t] = (i == t) ? 1.f : 0.f;
#pragma unroll
            for (int s2 = 0; s2 < 15; ++s2) {
#pragma unroll
                for (int t4 = (s2 + 1) & ~3; t4 < 16; t4 += 4) { const f32x4 l4 = *(const LAS f32x4*)(LA + sc * 256 + s2 * 16 + t4);
#pragma unroll
                    for (int e = 0; e < 4; ++e) if (t4 + e > s2) x[t4 + e] -= l4[e] * x[s2]; } }
            if (g == 0) {
#pragma unroll
                for (int t = 0; t < 16; ++t) UINV[sc * 256 + t * 16 + i] = (bf16)f2bf(x[t]); }
        }
        LDS_WAIT(); __syncthreads();
        if (wave < 4) {
            const int jv = wave;
#pragma unroll 2
            for (int sc = 0; sc < 4; ++sc) {
                const int r0 = 16 * sc;
                v4u xw0, xw1;
                xw0.x = pk2(X[0][0], X[0][1]); xw0.y = pk2(X[0][2], X[0][3]); xw0.z = pk2(X[1][0], X[1][1]); xw0.w = pk2(X[1][2], X[1][3]);
                xw1.x = pk2(X[2][0], X[2][1]); xw1.y = pk2(X[2][2], X[2][3]); xw1.z = pk2(X[3][0], X[3][1]); xw1.w = pk2(X[3][2], X[3][3]);
                const s16x8_t xb0 = __builtin_bit_cast(s16x8_t, xw0), xb1 = __builtin_bit_cast(s16x8_t, xw1);
                const s16x8_t vf = cat4(lds_tr4(VB + (r0 + 4 * g + q4) * RW_TS + 16 * jv + 4 * p4), z4);
                const int so = sc * 256 + i * 16 + 4 * g;
                f32x4 accB = MFMA16(cat4(*(const LAS s16x4_t*)(LK + so), z4), vf, ((f32x4){0.f, 0.f, 0.f, 0.f}));
                f32x4 accY = MFMA16(cat4(*(const LAS s16x4_t*)(G3M + so), z4), vf, ((f32x4){0.f, 0.f, 0.f, 0.f}));
                { const LAS bf16* kp = KAP + (r0 + i) * RW_TS + 4 * g; const LAS bf16* rp = RHAT + (r0 + i) * RW_TS + 4 * g;
                  accB = MFMA16(cat4(*(const LAS s16x4_t*)kp, *(const LAS s16x4_t*)(kp + 16)), xb0, accB); accB = MFMA16(cat4(*(const LAS s16x4_t*)(kp + 32), *(const LAS s16x4_t*)(kp + 48)), xb1, accB);
                  accY = MFMA16(cat4(*(const LAS s16x4_t*)rp, *(const LAS s16x4_t*)(rp + 16)), xb0, accY); accY = MFMA16(cat4(*(const LAS s16x4_t*)(rp + 32), *(const LAS s16x4_t*)(rp + 48)), xb1, accY); }
#pragma unroll
                for (int kt4 = 0; kt4 < 4; ++kt4) X[kt4] = MFMA16(cat4(lds_tr4(KHAT + (r0 + 4 * g + q4) * RW_TS + 16 * kt4 + 4 * p4), z4), vf, X[kt4]);
                v4u bw; bw.x = pk2(accB[0], accB[1]); bw.y = pk2(accB[2], accB[3]); bw.z = 0u; bw.w = 0u;
                const f32x4 accU = MFMA16(cat4(*(const LAS s16x4_t*)(UINV + so), z4), __builtin_bit_cast(s16x8_t, bw), ((f32x4){0.f, 0.f, 0.f, 0.f}));
                v4u uw; uw.x = pk2(-accU[0], -accU[1]); uw.y = pk2(-accU[2], -accU[3]); uw.z = 0u; uw.w = 0u;
                const s16x8_t unf = __builtin_bit_cast(s16x8_t, uw);
                accY = MFMA16(cat4(*(const LAS s16x4_t*)(G4M + so), z4), unf, accY);
#pragma unroll
                for (int kt4 = 0; kt4 < 4; ++kt4) { X[kt4] = MFMA16(cat4(lds_tr4(AHAT + (r0 + 4 * g + q4) * RW_TS + 16 * kt4 + 4 * p4), z4), unf, X[kt4]);
                    X[kt4] = X[kt4] * *(const LAS f32x4*)(GT + sc * 64 + 16 * kt4 + 4 * g); }
#pragma unroll
                for (int r = 0; r < 4; ++r) YY[(r0 + 4 * g + r) * 64 + 16 * jv + i] = accY[r];
            }
        }
        LDS_WAIT(); __syncthreads();
        {
            const int o = ltt * 64 + lcc * 8; const size_t gt = (size_t)b * SEQ + j * 64 + ltt;
            const f32x4 ya = *(const LAS f32x4*)(YY + o), yb = *(const LAS f32x4*)(YY + o + 4); const v4u vw = *(const LAS v4u*)(VB + ltt * RW_TS + lcc * 8);
            float y[8] = {ya[0], ya[1], ya[2], ya[3], yb[0], yb[1], yb[2], yb[3]};
            float vq[8] = {bflo(vw[0]), bfhi(vw[0]), bflo(vw[1]), bfhi(vw[1]), bflo(vw[2]), bfhi(vw[2]), bflo(vw[3]), bfhi(vw[3])};
            float gq[8] = {bflo(gk[0]), bfhi(gk[0]), bflo(gk[1]), bfhi(gk[1]), bflo(gk[2]), bfhi(gk[2]), bflo(gk[3]), bfhi(gk[3])};
            float s = 0.f;
#pragma unroll
            for (int e = 0; e < 8; ++e) s += y[e];
            const float mean = red8(s) * (1.f / 64.f); float q = 0.f;
#pragma unroll
            for (int e = 0; e < 8; ++e) { y[e] -= mean; q += y[e] * y[e]; }
            const float rstd = 1.0f / sqrtf(red8(q) * (1.f / 64.f) + GN_EPS), bd = BD[ltt];
            const LAS float* lp = PRM + 384 + lcc * 8; const f32x4 w0 = *(const LAS f32x4*)lp, w1 = *(const LAS f32x4*)(lp + 4), b0 = *(const LAS f32x4*)(lp + 64), b1 = *(const LAS f32x4*)(lp + 68);
            const float lw8[8] = {w0[0], w0[1], w0[2], w0[3], w1[0], w1[1], w1[2], w1[3]}, lb8[8] = {b0[0], b0[1], b0[2], b0[3], b1[0], b1[1], b1[2], b1[3]};
            float ov[8];
#pragma unroll
            for (int e = 0; e < 8; ++e) ov[e] = (y[e] * rstd * lw8[e] + lb8[e] + bd * vq[e]) * gq[e];
            *(GAS v4u*)(CAT + gt * D + 2048 + c0) = pack8(ov);
        }
        LDS_WAIT(); __syncthreads();
    }
}

constexpr int ML_QS = 264, ML_VS = 136, ML_PS = 72;
constexpr int ML_KS = 272, ML_VGS = 144, ML_QP = 272;
__device__ __forceinline__ void ml_scalars(LAS float* SC, int lane, float& mprev) {
    const float li = SC[lane], lf = SC[64 + lane];
    const float b = scan_add64(lf);
    const float gq = li - b, mx = scan_max64(gq);
    const float mm = fmaxf(mx, mprev);
    SC[128 + lane] = -mm; SC[192 + lane] = gq; SC[256 + lane] = expf(mprev - mm); SC[384 + lane] = expf(-(b + mm));
    const float blast = lane63(b), mlast = lane63(mx);
    const float mnew = fmaxf(blast + mprev, blast + mlast);
    SC[320 + lane] = expf(blast + gq - mnew);
    if (lane == 0) SC[448] = expf(blast + mprev - mnew);
    mprev = mnew;
}
struct MlRaw { v4u q[4], k[4], v[2]; float gi, gf; };
template <bool WITH_V> __device__ __forceinline__ void ml_load(MlRaw& R, const bf16* Z, const float* ZG, int b, int h, int dvs, int c, int row, int seg) {
    const int tid_ = row * 8 + seg;
    const bf16* z0 = Z + ((size_t)b * SEQ + c * 64) * LDZ1;
#pragma unroll
    for (int e = 0; e < 4; ++e) { const bf16* zr = z0 + (size_t)((tid_ >> 5) + 16 * e) * LDZ1 + h * 256 + (tid_ & 31) * 8; R.q[e] = *(const GAS v4u*)(zr + MC_Q); R.k[e] = *(const GAS v4u*)(zr + MC_K); }
    if (WITH_V) {
#pragma unroll
        for (int e = 0; e < 2; ++e) R.v[e] = *(const GAS v4u*)(z0 + (size_t)((tid_ >> 4) + 32 * e) * LDZ1 + MC_V + h * 512 + dvs * 128 + (tid_ & 15) * 8); }
    { const float* zp = ZG + (size_t)seg * M * 16 + ((size_t)b * SEQ + c * 64 + row) * 16 + h;
      R.gi = *(const GAS float*)zp; R.gf = *(const GAS float*)(zp + 8); }
}
template <int QP, int KP, bool QPERM> __device__ __forceinline__ f32x4 ml_s_tile(const LAS bf16* Qs, const LAS bf16* Ks, int lt, int st, int i, int g) {
    f32x4 acc = (f32x4){0.f, 0.f, 0.f, 0.f};
    const LAS bf16* qa = Qs + (16 * lt + i) * QP + 8 * g; const LAS bf16* kb = Ks + (16 * st + i) * KP + (QPERM ? 4 * g : 8 * g);
#pragma unroll
    for (int ks = 0; ks < 8; ++ks) acc = MFMA16(*(const LAS s16x8_t*)(qa + 32 * ks), QPERM ? cat4(*(const LAS s16x4_t*)(kb + 32 * ks), *(const LAS s16x4_t*)(kb + 32 * ks + 16)) : *(const LAS s16x8_t*)(kb + 32 * ks), acc);
    return acc;
}
__device__ __forceinline__ void mlstm_num_phase(LAS unsigned char* lds, const CAS Args* a, int w, int tid) {
    LAS bf16* Qs = (LAS bf16*)lds;
    LAS bf16* Ks = Qs + 64 * ML_QP;
    LAS bf16* Vs = Ks + 64 * ML_KS;
    LAS bf16* VGs = Vs + 64 * ML_VS;
    LAS bf16* Ps = VGs + 64 * ML_VGS;
    LAS float* SC = (LAS float*)(Ps + 64 * ML_PS);
    static_assert((64 * ML_QP + 64 * ML_KS + 2 * 64 * ML_VS + 64 * ML_VGS + 64 * ML_PS) * 2 + 2048 <= LDSCTL_OFF, "mLSTM numerator LDS map");
    LAS bf16* Os = (LAS bf16*)(SC + 512);
    const bf16* Z = (const bf16*)(a->ws + WS_Z); const float* ZG = (const float*)(a->ws + WS_ZP); bf16* NUM = (bf16*)(a->ws + WS_HRAW);
    const int bh = w >> 2, dvs = w & 3, b = bh >> 3, h = bh & 7, lane = tid & 63, wave = __builtin_amdgcn_readfirstlane(tid >> 6);
    const int row = tid >> 3, seg = tid & 7;
    const int i = lane & 15, g = lane >> 4, q4 = i >> 2, p4 = i & 3, dv0 = 16 * wave;
    const float bi = a->in[I_BI][h], bfv = a->in[I_BF][h];
    f32x4 C[16];
#pragma unroll
    for (int t = 0; t < 16; ++t) C[t] = (f32x4){0.f, 0.f, 0.f, 0.f};
    float mprev = 0.f;
    MlRaw R; ml_load<true>(R, Z, ZG, b, h, dvs, 0, row, seg);
    for (int c = 0; c < SEQ / 64; ++c) {
        __syncthreads();
#pragma unroll
        for (int e = 0; e < 4; ++e) { const int ch = tid & 31; LAS bf16* qd = Qs + ((tid >> 5) + 16 * e) * ML_QP + 32 * (ch >> 2) + 16 * (ch & 1) + 4 * ((ch >> 1) & 1);
            *(LAS v2u*)qd = (v2u){R.q[e].x, R.q[e].y}; *(LAS v2u*)(qd + 8) = (v2u){R.q[e].z, R.q[e].w};
            *(LAS v4u*)(Ks + ((tid >> 5) + 16 * e) * ML_KS + (tid & 31) * 8) = R.k[e]; }
#pragma unroll
        for (int e = 0; e < 2; ++e) *(LAS v4u*)(Vs + ((tid >> 4) + 32 * e) * ML_VS + (tid & 15) * 8) = R.v[e];
        { const float gi = red8(R.gi), gf = red8(R.gf); if (seg == 0) { SC[row] = gi + bi; SC[64 + row] = flogsig(gf + bfv); } }
        const v4u vk0 = R.v[0], vk1 = R.v[1];
        if (c + 1 < SEQ / 64) ml_load<true>(R, Z, ZG, b, h, dvs, c + 1, row, seg);
        if (c > 0) { const LAS v4u* op = (const LAS v4u*)(Os + row * ML_VS + seg * 16); const v4u o0 = op[0], o1 = op[1];
            GAS v4u* gp = (GAS v4u*)(NUM + ((size_t)b * SEQ + (c - 1) * 64 + row) * D + h * 512 + dvs * 128 + seg * 16); gp[0] = o0; gp[1] = o1; }
        LDS_WAIT(); __syncthreads();
        if (wave == 0) ml_scalars(SC, lane, mprev);
        LDS_WAIT(); __syncthreads();
#pragma unroll
        for (int e = 0; e < 2; ++e) { const int vr = (tid >> 4) + 32 * e; const float gw = SC[320 + vr]; const v4u vv = e ? vk1 : vk0; v4u o;
#pragma unroll
            for (int x = 0; x < 4; ++x) o[x] = pk2(bflo(vv[x]) * gw, bfhi(vv[x]) * gw);
            *(LAS v4u*)(VGs + vr * ML_VGS + (tid & 15) * 8) = o; }
        { const int lt = wave >> 1;
#pragma unroll
          for (int hh = 0; hh < 2; ++hh) { const int st = 2 * (wave & 1) + hh;
              f32x4 pv = (f32x4){0.f, 0.f, 0.f, 0.f};
              if (st <= lt) { const f32x4 acc = ml_s_tile<ML_QP, ML_KS, true>(Qs, Ks, lt, st, i, g); const f32x4 rt = *(const LAS f32x4*)(SC + 128 + 16 * lt + 4 * g); const float ct = SC[192 + 16 * st + i];
#pragma unroll
                  for (int r = 0; r < 4; ++r) pv[r] = (16 * st + i <= 16 * lt + 4 * g + r) ? acc[r] * 0.0625f * fexp2(1.4426950408889634f * (rt[r] + ct)) : 0.f; }
#pragma unroll
              for (int r = 0; r < 4; ++r) Ps[(16 * lt + 4 * g + r) * ML_PS + 16 * st + i] = (bf16)f2bf(pv[r]); } }
        LDS_WAIT(); __syncthreads();
        f32x4 nA[4], nB[4];
#pragma unroll
        for (int lt = 0; lt < 4; ++lt) { nA[lt] = (f32x4){0.f, 0.f, 0.f, 0.f}; nB[lt] = (f32x4){0.f, 0.f, 0.f, 0.f}; }
#pragma unroll
        for (int ks = 0; ks < 2; ++ks) { const LAS bf16* vp = Vs + (32 * ks + 8 * g + q4) * ML_VS + dv0 + 4 * p4;
            const s16x8_t bv = cat4(lds_tr4(vp), lds_tr4(vp + 4 * ML_VS));
#pragma unroll
            for (int lt = 0; lt < 4; ++lt) nA[lt] = MFMA16(*(const LAS s16x8_t*)(Ps + (16 * lt + i) * ML_PS + 32 * ks + 8 * g), bv, nA[lt]); }
        { s16x8_t qa[3][4];
#define ML_LDQ(dst, KS) _Pragma("unroll") for (int lt = 0; lt < 4; ++lt) dst[lt] = *(const LAS s16x8_t*)(Qs + (16 * lt + i) * ML_QP + 32 * (KS) + 8 * g);
          ML_LDQ(qa[0], 0) ML_LDQ(qa[1], 1)
          __builtin_amdgcn_sched_barrier(0);
#pragma unroll
          for (int ks = 0; ks < 8; ++ks) {
              if (ks + 2 < 8) { ML_LDQ(qa[(ks + 2) % 3], ks + 2) }
              v4u cw; cw.x = pk2(C[2 * ks][0], C[2 * ks][1]); cw.y = pk2(C[2 * ks][2], C[2 * ks][3]); cw.z = pk2(C[2 * ks + 1][0], C[2 * ks + 1][1]); cw.w = pk2(C[2 * ks + 1][2], C[2 * ks + 1][3]);
              const s16x8_t bc = __builtin_bit_cast(s16x8_t, cw);
#pragma unroll
              for (int lt = 0; lt < 4; ++lt) nB[lt] = MFMA16(qa[ks % 3][lt], bc, nB[lt]);
              __builtin_amdgcn_sched_barrier(0);
          }
#undef ML_LDQ
        }
        { s16x8_t ka[3][4], bv[2];
#define ML_LDK(dst, BQ) _Pragma("unroll") for (int u = 0; u < 4; ++u) { const LAS bf16* kp = Ks + (32 * ((BQ) >> 2) + 4 * g + q4) * ML_KS + 4 * p4 + 16 * (4 * ((BQ) & 3) + u); dst[u] = cat4(lds_tr4(kp), lds_tr4(kp + 16 * ML_KS)); }
          f32x4 it4[4];
#pragma unroll
          for (int lt = 0; lt < 4; ++lt) it4[lt] = *(const LAS f32x4*)(SC + 256 + 16 * lt + 4 * g);
          const float cd = SC[448];
#pragma unroll
          for (int ks = 0; ks < 2; ++ks) { const LAS bf16* vp = VGs + (32 * ks + 4 * g + q4) * ML_VGS + dv0 + 4 * p4; bv[ks] = cat4(lds_tr4(vp), lds_tr4(vp + 16 * ML_VGS)); }
          ML_LDK(ka[0], 0) ML_LDK(ka[1], 1)
          __builtin_amdgcn_sched_barrier(0);
#pragma unroll
          for (int lt = 0; lt < 4; ++lt) {
#pragma unroll
              for (int r = 0; r < 4; ++r) Os[(16 * lt + 4 * g + r) * ML_VS + dv0 + i] = (bf16)f2bf(nA[lt][r] + it4[lt][r] * 0.0625f * nB[lt][r]); }
#pragma unroll
          for (int t = 0; t < 16; ++t) C[t] = C[t] * cd;
          __builtin_amdgcn_sched_barrier(0);
#pragma unroll
          for (int bq = 0; bq < 8; ++bq) {
              if (bq + 2 < 8) { ML_LDK(ka[(bq + 2) % 3], bq + 2) }
#pragma unroll
              for (int u = 0; u < 4; ++u) C[4 * (bq & 3) + u] = MFMA16(ka[bq % 3][u], bv[bq >> 2], C[4 * (bq & 3) + u]);
              __builtin_amdgcn_sched_barrier(0);
          }
#undef ML_LDK
        }
    }
    LDS_WAIT(); __syncthreads();
    { const LAS v4u* op = (const LAS v4u*)(Os + row * ML_VS + seg * 16); const v4u o0 = op[0], o1 = op[1];
      GAS v4u* gp = (GAS v4u*)(NUM + ((size_t)b * SEQ + (SEQ - 64) + row) * D + h * 512 + dvs * 128 + seg * 16); gp[0] = o0; gp[1] = o1; }
}
__device__ __forceinline__ void mlstm_den_phase(LAS unsigned char* lds, const CAS Args* a, int bh, int tid) {
    LAS bf16* Qs = (LAS bf16*)lds; LAS bf16* Ks = Qs + 64 * ML_QS;
    LAS float* SC = (LAS float*)(Ks + 64 * ML_QS);
    LAS float* NS = SC + 512;
    LAS float* NP = NS + 256;
    LAS float* ROWP = NP + 512;
    LAS float* QN = ROWP + 256;
    const bf16* Z = (const bf16*)(a->ws + WS_Z); const float* ZG = (const float*)(a->ws + WS_ZP); float* DENG = (float*)(a->ws + WS_HSSQ); float* EMTG = DENG + (size_t)M * 8;
    const int b = bh >> 3, h = bh & 7, lane = tid & 63, wave = __builtin_amdgcn_readfirstlane(tid >> 6);
    const int row = tid >> 3, seg = tid & 7, i = lane & 15, g = lane >> 4;
    const float bi = a->in[I_BI][h], bfv = a->in[I_BF][h];
    if (tid < 256) NS[tid] = 0.f;
    float mprev = 0.f;
    MlRaw R; ml_load<false>(R, Z, ZG, b, h, 0, 0, row, seg);
    for (int c = 0; c < SEQ / 64; ++c) {
        __syncthreads();
#pragma unroll
        for (int e = 0; e < 4; ++e) { *(LAS v4u*)(Qs + ((tid >> 5) + 16 * e) * ML_QS + (tid & 31) * 8) = R.q[e]; *(LAS v4u*)(Ks + ((tid >> 5) + 16 * e) * ML_QS + (tid & 31) * 8) = R.k[e]; }
        { const float gi = red8(R.gi), gf = red8(R.gf); if (seg == 0) { SC[row] = gi + bi; SC[64 + row] = flogsig(gf + bfv); } }
        if (c + 1 < SEQ / 64) ml_load<false>(R, Z, ZG, b, h, 0, c + 1, row, seg);
        LDS_WAIT(); __syncthreads();
        if (wave == 0) ml_scalars(SC, lane, mprev);
        LDS_WAIT(); __syncthreads();
        { const int lt = wave >> 1;
#pragma unroll
          for (int hh = 0; hh < 2; ++hh) { const int st = 2 * (wave & 1) + hh;
              f32x4 pv = (f32x4){0.f, 0.f, 0.f, 0.f};
              if (st <= lt) { const f32x4 acc = ml_s_tile<ML_QS, ML_QS, false>(Qs, Ks, lt, st, i, g); const f32x4 rt = *(const LAS f32x4*)(SC + 128 + 16 * lt + 4 * g); const float ct = SC[192 + 16 * st + i];
#pragma unroll
                  for (int r = 0; r < 4; ++r) pv[r] = (16 * st + i <= 16 * lt + 4 * g + r) ? bf2f((bf16)f2bf(acc[r] * 0.0625f * fexp2(1.4426950408889634f * (rt[r] + ct)))) : 0.f; }
#pragma unroll
              for (int r = 0; r < 4; ++r) { const float s = red16(pv[r]); if (i == 0) ROWP[st * 64 + 16 * lt + 4 * g + r] = s; } } }
        { float acc = 0.f; const LAS bf16* qp = Qs + row * ML_QS + seg * 32; const LAS float* np = NS + seg * 32;
#pragma unroll
          for (int e = 0; e < 4; ++e) { const v4u qw = *(const LAS v4u*)(qp + 8 * e);
#pragma unroll
              for (int x = 0; x < 4; ++x) acc += bflo(qw[x]) * np[8 * e + 2 * x] + bfhi(qw[x]) * np[8 * e + 2 * x + 1]; }
          acc = red8(acc); if (seg == 0) QN[row] = acc; }
        LDS_WAIT(); __syncthreads();
        if (tid < 64) { const size_t t = (size_t)b * SEQ + c * 64 + tid;
            const float den = ((ROWP[tid] + ROWP[64 + tid]) + (ROWP[128 + tid] + ROWP[192 + tid])) + SC[256 + tid] * 0.0625f * QN[tid];
            DENG[t * 8 + h] = den; EMTG[t * 8 + h] = SC[384 + tid]; }
        { const int d = tid & 255, hf = tid >> 8; float acc = 0.f;
#pragma unroll 8
          for (int s = 0; s < 32; ++s) acc += bf2f(Ks[(hf * 32 + s) * ML_QS + d]) * SC[320 + hf * 32 + s];
          NP[hf * 256 + d] = acc; }
        LDS_WAIT(); __syncthreads();
        if (tid < 256) NS[tid] = SC[448] * NS[tid] + (NP[tid] + NP[256 + tid]);
    }
}
__device__ __forceinline__ void mlstm_post(const CAS Args* a, int gwave, int lane) {
    const bf16* Z = (const bf16*)(a->ws + WS_Z); const bf16* NUM = (const bf16*)(a->ws + WS_HRAW); const float* DENG = (const float*)(a->ws + WS_HSSQ); const float* EMTG = DENG + (size_t)M * 8;
    bf16* CAT = (bf16*)(a->ws + WS_CAT); const float* nw = a->in[I_MLNORM];
    for (int t = gwave; t < M; t += GRID * NWAVES) {
        f32x4 h0[8], h1[8]; v4u zo[8]; float q[8];
#pragma unroll
        for (int hd = 0; hd < 8; ++hd) { const int col = hd * 512 + lane * 8; const v4u hw = *(const GAS v4u*)(NUM + (size_t)t * D + col); h0[hd] = (f32x4){bflo(hw[0]), bfhi(hw[0]), bflo(hw[1]), bfhi(hw[1])}; h1[hd] = (f32x4){bflo(hw[2]), bfhi(hw[2]), bflo(hw[3]), bfhi(hw[3])};
            zo[hd] = *(const GAS v4u*)(Z + (size_t)t * LDZ1 + MC_O + col); }
#pragma unroll
        for (int hd = 0; hd < 8; ++hd) { const float den = ((const GAS float*)DENG)[t * 8 + hd], emt = ((const GAS float*)EMTG)[t * 8 + hd], dinv = 1.0f / fmaxf(fabsf(den), emt);
            h0[hd] = h0[hd] * dinv; h1[hd] = h1[hd] * dinv;
            q[hd] = ((h0[hd][0] * h0[hd][0] + h0[hd][1] * h0[hd][1]) + (h0[hd][2] * h0[hd][2] + h0[hd][3] * h0[hd][3])) + ((h1[hd][0] * h1[hd][0] + h1[hd][1] * h1[hd][1]) + (h1[hd][2] * h1[hd][2] + h1[hd][3] * h1[hd][3])); }
#pragma unroll
        for (int o = 1; o < 64; o <<= 1)
#pragma unroll
            for (int hd = 0; hd < 8; ++hd) q[hd] += __shfl_xor(q[hd], o);
#pragma unroll
        for (int hd = 0; hd < 8; ++hd) { const int col = hd * 512 + lane * 8; const float rs = 1.0f / sqrtf(q[hd] * (1.f / 512.f) + NORM_EPS);
            const f32x4 n0 = *(const f32x4*)(nw + col), n1 = *(const f32x4*)(nw + col + 4); float o[8];
#pragma unroll
            for (int x = 0; x < 4; ++x) { o[x] = h0[hd][x] * rs * n0[x]; o[4 + x] = h1[hd][x] * rs * n1[x]; }
#pragma unroll
            for (int x = 0; x < 4; ++x) { o[2 * x] *= fsigmoid(bflo(zo[hd][x])); o[2 * x + 1] *= fsigmoid(bfhi(zo[hd][x])); }
            v4u w; w.x = pk2(o[0], o[1]); w.y = pk2(o[2], o[3]); w.z = pk2(o[4], o[5]); w.w = pk2(o[6], o[7]);
            *(GAS v4u*)(CAT + (size_t)t * D + col) = w; }
    }
}
struct LruRaw { v4u z[4][4]; v4u gz; };
__device__ __forceinline__ void lru_load(LruRaw& R, const bf16* Z, int b, int hh, int slab, int j, int tt, int c8) {
    const int tpos = j * 64 + tt; const bf16* zrow = Z + ((size_t)b * SEQ + tpos) * LDZ0 + hh * 256;
#pragma unroll
    for (int e = 0; e < 4; ++e)
#pragma unroll
        for (int d = 0; d < 4; ++d) R.z[e][d] = (tpos - d >= 0) ? *(const GAS v4u*)(zrow - (size_t)d * LDZ0 + (c8 + 8 * e) * 8) : (v4u){0u, 0u, 0u, 0u};
    R.gz = *(const GAS v4u*)(zrow + 2048 + slab * 64 + c8 * 8);
}
__device__ __forceinline__ void rglru_phase(LAS unsigned char* lds, const CAS Args* a, int w, int tid) {
    LAS bf16* UCB = (LAS bf16*)lds;
    LAS float* RI = (LAS float*)(UCB + 64 * 264);
    LAS float* UCO = RI + 8192;
    LAS float* G_ = UCO + 4096;
    LAS float* CW = G_ + 4096;
    LAS float* SEG = CW + 1280;
    LAS float* HC = SEG + 1024;
    const bf16* Z = (const bf16*)(a->ws + WS_Z); bf16* CAT = (bf16*)(a->ws + WS_CAT);
    const float* cw = a->in[I_CONVW]; const float* cb = a->in[I_CONVB];
    const float* ba = a->in[I_BA]; const float* bx = a->in[I_BX]; const float* lam = a->in[I_LAM];
    const int b = w >> 5, hh = (w >> 2) & 7, slab = w & 3, lane = tid & 63, wave = __builtin_amdgcn_readfirstlane(tid >> 6);
    const int stt = tid >> 3, sc8 = tid & 7;
    const int jch = tid & 63, sg = tid >> 6, c = hh * 256 + slab * 64 + jch;
    const int i = lane & 15, g = lane >> 4, mt = wave >> 2, ct = wave & 3;
    for (int u = tid; u < 1280; u += NTHR) CW[u] = (u < 1024) ? cw[(u >> 8) * 2048 + hh * 256 + (u & 255)] : cb[hh * 256 + (u - 1024)];
    if (tid < 128) HC[tid] = 0.f;
    const float sp = softplusf_(-lam[c]), bav = ba[c], bxv = bx[c];
    s16x8_t bw[8];
    { const bf16* wt = (const bf16*)(a->ws + (mt ? WS_WXT : WS_WAT)) + (size_t)(slab * 64 + ct * 16 + i) * 2048 + hh * 256 + 8 * g;
#pragma unroll
      for (int ks = 0; ks < 8; ++ks) bw[ks] = *(const GAS s16x8_t*)(wt + 32 * ks); }
    LruRaw R; lru_load(R, Z, b, hh, slab, 0, stt, sc8);
    LDS_WAIT(); __syncthreads();
    for (int j = 0; j < SEQ / 64; ++j) {
#pragma unroll
        for (int e = 0; e < 4; ++e) { const int ch = (sc8 + 8 * e) * 8; float acc[8];
#pragma unroll
            for (int x = 0; x < 8; x += 4) { const f32x4 bb = *(const LAS f32x4*)(CW + 1024 + ch + x); acc[x] = bb[0]; acc[x + 1] = bb[1]; acc[x + 2] = bb[2]; acc[x + 3] = bb[3]; }
#pragma unroll
            for (int d = 0; d < 4; ++d) { const f32x4 w0 = *(const LAS f32x4*)(CW + (3 - d) * 256 + ch), w1 = *(const LAS f32x4*)(CW + (3 - d) * 256 + ch + 4); const v4u zz = R.z[e][d];
                acc[0] += w0[0] * bflo(zz[0]); acc[1] += w0[1] * bfhi(zz[0]); acc[2] += w0[2] * bflo(zz[1]); acc[3] += w0[3] * bfhi(zz[1]);
                acc[4] += w1[0] * bflo(zz[2]); acc[5] += w1[1] * bfhi(zz[2]); acc[6] += w1[2] * bflo(zz[3]); acc[7] += w1[3] * bfhi(zz[3]); }
            v4u o; o.x = pk2(acc[0], acc[1]); o.y = pk2(acc[2], acc[3]); o.z = pk2(acc[4], acc[5]); o.w = pk2(acc[6], acc[7]);
            *(LAS v4u*)(UCB + stt * 264 + ch) = o;
            if ((sc8 + 8 * e) >> 3 == slab) { LAS float* uo = UCO + stt * 64 + (ch - slab * 64); *(LAS f32x4*)uo = (f32x4){acc[0], acc[1], acc[2], acc[3]}; *(LAS f32x4*)(uo + 4) = (f32x4){acc[4], acc[5], acc[6], acc[7]}; } }
        { LAS float* gp = G_ + stt * 64 + sc8 * 8; const v4u zz = R.gz;
          *(LAS f32x4*)gp = (f32x4){fgelu_tanh(bflo(zz[0])), fgelu_tanh(bfhi(zz[0])), fgelu_tanh(bflo(zz[1])), fgelu_tanh(bfhi(zz[1]))};
          *(LAS f32x4*)(gp + 4) = (f32x4){fgelu_tanh(bflo(zz[2])), fgelu_tanh(bfhi(zz[2])), fgelu_tanh(bflo(zz[3])), fgelu_tanh(bfhi(zz[3]))}; }
        LDS_WAIT(); __syncthreads();
        if (j + 1 < SEQ / 64) lru_load(R, Z, b, hh, slab, j + 1, stt, sc8);
        { f32x4 acc[4];
#pragma unroll
          for (int t4 = 0; t4 < 4; ++t4) acc[t4] = (f32x4){0.f, 0.f, 0.f, 0.f};
#pragma unroll
          for (int ks = 0; ks < 8; ++ks)
#pragma unroll
              for (int t4 = 0; t4 < 4; ++t4) acc[t4] = MFMA16(*(const LAS s16x8_t*)(UCB + (16 * t4 + i) * 264 + 32 * ks + 8 * g), bw[ks], acc[t4]);
#pragma unroll
          for (int t4 = 0; t4 < 4; ++t4)
#pragma unroll
              for (int r = 0; r < 4; ++r) RI[mt * 4096 + (16 * t4 + 4 * g + r) * 64 + ct * 16 + i] = acc[t4][r]; }
        LDS_WAIT(); __syncthreads();
        float av[8], bv[8]; float pp = 1.f, hl = 0.f;
#pragma unroll
        for (int t8 = 0; t8 < 8; ++t8) { const int tt = sg * 8 + t8;
            const float rg = fsigmoid(RI[tt * 64 + jch] + bav), ig = fsigmoid(RI[4096 + tt * 64 + jch] + bxv), la = -8.0f * rg * sp;
            av[t8] = fexp(la); bv[t8] = __builtin_amdgcn_sqrtf(fmaxf(__builtin_fmaf(-av[t8], av[t8], 1.f), 0.f)) * (ig * UCO[tt * 64 + jch]);
            pp *= av[t8]; hl = av[t8] * hl + bv[t8]; }
        SEG[(sg * 64 + jch) * 2] = pp; SEG[(sg * 64 + jch) * 2 + 1] = hl;
        LDS_WAIT(); __syncthreads();
        { float hc = HC[(j & 1) * 64 + jch];
          for (int s2 = 0; s2 < sg; ++s2) hc = SEG[(s2 * 64 + jch) * 2] * hc + SEG[(s2 * 64 + jch) * 2 + 1];
#pragma unroll
          for (int t8 = 0; t8 < 8; ++t8) { const int tt = sg * 8 + t8; hc = av[t8] * hc + bv[t8]; RI[tt * 64 + jch] = hc * G_[tt * 64 + jch]; }
          if (sg == 7) HC[((j + 1) & 1) * 64 + jch] = hc; }
        LDS_WAIT(); __syncthreads();
        { const int tt = tid >> 3, c8 = (tid & 7) * 8; const f32x4 p = *(const LAS f32x4*)(RI + tt * 64 + c8), q = *(const LAS f32x4*)(RI + tt * 64 + c8 + 4);
          v4u o; o.x = pk2(p[0], p[1]); o.y = pk2(p[2], p[3]); o.z = pk2(q[0], q[1]); o.w = pk2(q[2], q[3]);
          *(GAS v4u*)(CAT + ((size_t)b * SEQ + j * 64 + tt) * D + hh * 256 + slab * 64 + c8) = o; }
        LDS_WAIT(); __syncthreads();
    }
}
__device__ __forceinline__ void final_norm(const CAS Args* a, int vcu, int wave, int lane) {
    const float* gw_ = a->in[I_NFIN]; const bf16* XB = (const bf16*)(a->ws + WS_XB); const int gw = vcu * NWAVES + wave, NGW = GRID * NWAVES;
    for (int m = gw; m < M; m += NGW) {
        const GAS v4u* xr = (const GAS v4u*)(XB + (size_t)m * D) + lane; v4u v[8]; float s = 0.f;
#pragma unroll
        for (int j = 0; j < 8; ++j) { v[j] = xr[64 * j];
#pragma unroll
            for (int x = 0; x < 4; ++x) { const float lo = bflo(v[j][x]), hi = bfhi(v[j][x]); s += lo * lo + hi * hi; } }
        const float rstd = 1.0f / sqrtf(wave_sum(s) * (1.0f / D) + NORM_EPS);
        GAS f32x4* orow = (GAS f32x4*)(a->out + (size_t)m * D);
#pragma unroll
        for (int j = 0; j < 8; ++j) { const int c8 = (lane + 64 * j) * 8; const f32x4 g0 = *(const f32x4*)(gw_ + c8), g1 = *(const f32x4*)(gw_ + c8 + 4);
            orow[c8 / 4] = (f32x4){bflo(v[j][0]) * rstd * g0[0], bfhi(v[j][0]) * rstd * g0[1], bflo(v[j][1]) * rstd * g0[2], bfhi(v[j][1]) * rstd * g0[3]};
            orow[c8 / 4 + 1] = (f32x4){bflo(v[j][2]) * rstd * g1[0], bfhi(v[j][2]) * rstd * g1[1], bflo(v[j][3]) * rstd * g1[2], bfhi(v[j][3]) * rstd * g1[3]}; }
    }
}

__device__ __forceinline__ const CAS Args* fresh_args() { const CAS Args* p = (const CAS Args*)__builtin_amdgcn_kernarg_segment_ptr(); asm volatile("" : "+s"(p)); return p; }
__device__ __forceinline__ bool in_phase(int k) { const CAS Args* p = fresh_args(); return p->ph_lo <= k && k < p->ph_hi; }
__device__ __forceinline__ int fresh_tid() { int t = threadIdx.x; asm volatile("" : "+v"(t)); return t; }
__device__ __forceinline__ int vcu_of() { const int bx = blockIdx.x; return (bx % 8) * (GRID / 8) + bx / 8; }
__device__ __forceinline__ void seam(LAS unsigned char* lds, int k) {
    if (MK_N_LAUNCHES != 1) return;
    if (in_phase(k) && in_phase(k + 1)) { const CAS Args* a = fresh_args(); XcdBarrier bar; bar.bar = (unsigned*)(a->ws + WS_CTL) + CW_BAR; bar.x = xb_xcc_id(); bar.st = (volatile LAS unsigned*)(lds + MISC_OFF) + 8; xcd_barrier(bar); }
}
template <int L> __device__ __forceinline__ void layer_phases(LAS unsigned char* lds) {
    constexpr int p_in = 1 + 7 * L, p_out = 5 + 6 * L, p_up = 6 + 6 * L, p_down = 7 + 6 * L;
    if (in_phase(p_in)) {
        const CAS Args* a = fresh_args(); unsigned char* ws = a->ws; const int tid = fresh_tid(); constexpr int ldz = L ? LDZ1 : LDZ0;
        pg8::Gemm g{(const bf16*)(ws + WS_XB), (const bf16*)(ws + (L ? WS_WMLIN : WS_WHYIN)), D, D, D};
        LAS float* rstab = (LAS float*)(lds + RS_OFF);
        if (L == 1) {
          constexpr int nmain = 12288;
          pg8::StaticOrder S; S.init(M, nmain, GRID, blockIdx.x);
          build_rs(rstab, S, (const float*)(ws + WS_SSQ), 64, tid);
          pg8::EpiScale<0> E{(bf16*)(ws + WS_Z), ldz, rstab};
          pg8::gemm_phase<pg8::EpiScale<0>, pg8::StaticOrder, true, true>(lds, g, S, E);
          const CAS Args* a2 = fresh_args(); unsigned char* ws2 = a2->ws; const int tid2 = fresh_tid();
          constexpr int SK = 8, KC = D / SK, NREM = 16;
          pg8::Gemm g2{(const bf16*)(ws2 + WS_XB), (const bf16*)(ws2 + WS_WMLIN) + (size_t)nmain * D, D, D, KC};
          pg8::SplitOrder S2; S2.init(M / 256, 1, SK, KC, GRID, blockIdx.x);
          build_rs(rstab, S2, (const float*)(ws2 + WS_SSQ), 64, tid2);
          pg8::EpiPartial E2{(float*)(ws2 + WS_ZP), NREM, NREM, M, rstab};
          pg8::gemm_phase<pg8::EpiPartial, pg8::SplitOrder, true, true>(lds, g2, S2, E2);
        } else if (blockIdx.x < G1_WGS) {
          pg8::StaticOrder S; S.init(M, LDZ0, G1_WGS, blockIdx.x);
          build_rs(rstab, S, (const float*)(ws + WS_SSQ), 1, tid);
          pg8::EpiScale<0> E{(bf16*)(ws + WS_Z), ldz, rstab};
          pg8::gemm_phase<pg8::EpiScale<0>, pg8::StaticOrder, true, true>(lds, g, S, E);
        } else {
          const int t2 = fresh_tid(); const int wv = __builtin_amdgcn_readfirstlane(t2 >> 6);
          conv_range(lds, fresh_args(), CONV_A0, CONV_A, (blockIdx.x - G1_WGS) * NWAVES + wv, (GRID - G1_WGS) * NWAVES, wv, t2 & 63);
        }
    }
    seam(lds, p_in);
    if (L == 0) {
        if (in_phase(2)) rwkv_prepass(fresh_args(), vcu_of() * NTHR + fresh_tid());
        seam(lds, 2);
        if (in_phase(3)) {
            for (int q = 0; q < 3; ++q) {
                const CAS Args* a = fresh_args(); unsigned char* ws = a->ws;
                const int kq = (q == 2) ? 256 : 128;
                pg8::Gemm g{(const bf16*)(ws + (q == 0 ? WS_AW : (q == 1 ? WS_AAL : WS_AG))), (const bf16*)(ws + (q == 0 ? WS_W2T : (q == 1 ? WS_A2T : WS_G2T))), kq, kq, kq};
                pg8::StaticOrder S; S.init(M, 2048, GRID, blockIdx.x);
                pg8::EpiLora E{(bf16*)(ws + (q == 0 ? WS_DEC : (q == 1 ? WS_AA : WS_GG))), 2048, q == 0 ? a->in[I_W0] : a->in[I_A0], q};
                pg8::gemm_phase<pg8::EpiLora, pg8::StaticOrder, true, true>(lds, g, S, E);
            }
        }
        seam(lds, 3);
        if (in_phase(4)) { const int vcu = vcu_of(); if (vcu < 128) rwkv_phase(lds, fresh_args(), vcu, fresh_tid()); else rglru_phase(lds, fresh_args(), vcu - 128, fresh_tid());
            conv_queue(lds, fresh_args(), CONV_A, CONV_B, 0, fresh_tid()); }
        seam(lds, 4);
    } else {
        if (in_phase(9)) { const int vcu = vcu_of(); if (vcu < 128) mlstm_num_phase(lds, fresh_args(), vcu, fresh_tid()); else if (vcu < 160) mlstm_den_phase(lds, fresh_args(), vcu - 128, fresh_tid());
            conv_queue(lds, fresh_args(), CONV_B, CONV_TOTAL, 1, fresh_tid()); }
        seam(lds, 9);
        if (in_phase(10)) { const int tid = fresh_tid(); mlstm_post(fresh_args(), vcu_of() * NWAVES + __builtin_amdgcn_readfirstlane(tid >> 6), tid & 63); }
        seam(lds, 10);
    }
    if (in_phase(p_out)) {
        const CAS Args* a = fresh_args(); unsigned char* ws = a->ws;
        pg8::Gemm g{(const bf16*)(ws + WS_CAT), (const bf16*)(ws + (L ? WS_WMLOUT : WS_WHYOUT)), D, D, D};
        pg8::StaticOrder S; S.init(M, D, GRID, blockIdx.x);
        pg8::EpiResid<false> E{(const bf16*)(ws + WS_XB), (bf16*)(ws + WS_XB), (float*)nullptr, (float*)(ws + WS_SSQ), D};
        pg8::gemm_phase<pg8::EpiResid<false>, pg8::StaticOrder, true, true>(lds, g, S, E);
    }
    seam(lds, p_out);
    if (in_phase(p_up)) {
        const CAS Args* a = fresh_args(); unsigned char* ws = a->ws; const int tid = fresh_tid();
        pg8::Gemm g{(const bf16*)(ws + WS_XB), (const bf16*)(ws + WS_WUP + (size_t)L * FF * D * 2), D, D, D};
        pg8::StaticOrder S; S.init(M, FF, GRID, blockIdx.x);
        LAS float* rstab = (LAS float*)(lds + RS_OFF);
        build_rs(rstab, S, (const float*)(ws + WS_SSQ), 64, tid);
        pg8::EpiScale<1> E{(bf16*)(ws + WS_U), FF, rstab};
        pg8::gemm_phase<pg8::EpiScale<1>, pg8::StaticOrder, true, true>(lds, g, S, E);
    }
    seam(lds, p_up);
    if (in_phase(p_down)) {
        const CAS Args* a = fresh_args(); unsigned char* ws = a->ws;
        pg8::Gemm g{(const bf16*)(ws + WS_U), (const bf16*)(ws + WS_WDOWN + (size_t)L * FF * D * 2), FF, FF, FF};
        pg8::StaticOrder S; S.init(M, D, GRID, blockIdx.x);
        pg8::EpiResid<false> E{(const bf16*)(ws + WS_XB), (bf16*)(ws + WS_XB), (float*)nullptr, (float*)(ws + WS_SSQ), D};
        pg8::gemm_phase<pg8::EpiResid<false>, pg8::StaticOrder, true, true>(lds, g, S, E);
    }
    seam(lds, p_down);
}
__global__ void __launch_bounds__(NTHR, 2) fwd_kernel(Args args) {
    extern __shared__ __attribute__((aligned(16))) unsigned char lds_raw[];
    LAS unsigned char* lds = (LAS unsigned char*)lds_raw;
    { const int tid = threadIdx.x;
      for (int u = tid; u < (LDS_BYTES - LDSCTL_OFF) / 4; u += NTHR) ((LAS unsigned*)(lds + LDSCTL_OFF))[u] = 0u;
      __syncthreads();
      if (MK_N_LAUNCHES == 1) { const CAS Args* a = fresh_args(); (void)xcd_barrier_post((unsigned*)(a->ws + WS_CTL) + CW_BAR, (volatile LAS unsigned*)(lds + MISC_OFF) + 8); } }
    if (in_phase(0)) { const int tid = fresh_tid(); p0_prologue(lds, fresh_args(), vcu_of(), __builtin_amdgcn_readfirstlane(tid >> 6), tid & 63); }
    seam(lds, 0);
    layer_phases<0>(lds);
    layer_phases<1>(lds);
    if (in_phase(14)) { const int tid = fresh_tid(); final_norm(fresh_args(), vcu_of(), __builtin_amdgcn_readfirstlane(tid >> 6), tid & 63); }
}

extern "C" void kernel_launch(void* const* d_in, const int* in_sizes, int n_in, void* d_out, int out_size, void* d_ws, size_t ws_size, hipStream_t stream) {
    static int ready = 0;
    if (ready == 0) {
        if (n_in != 31 || out_size != M * D || ws_size < WS_END) { fprintf(stderr, "kernel_launch: unexpected shapes (n_in %d, out %d, ws %zu < %zu); nothing launched\n", n_in, out_size, ws_size, (size_t)WS_END); ready = -1; return; }
        if (hipFuncSetAttribute((const void*)fwd_kernel, hipFuncAttributeMaxDynamicSharedMemorySize, LDS_BYTES) != hipSuccess) { fprintf(stderr, "kernel_launch: hipFuncSetAttribute failed\n"); ready = -1; return; }
        int per_cu = 0;
        if (hipOccupancyMaxActiveBlocksPerMultiprocessor(&per_cu, (const void*)fwd_kernel, NTHR, LDS_BYTES) != hipSuccess || per_cu < 1)
            fprintf(stderr, "kernel_launch: note: occupancy query reports %d workgroups per CU\n", per_cu);
        (void)hipGetLastError();
        ready = 1;
    }
    if (ready < 0) return;
    if (hipMemsetAsync((char*)d_ws + WS_CTL, 0, CTL_ZERO_BYTES, stream) != hipSuccess) { fprintf(stderr, "kernel_launch: memset failed\n"); return; }
    Args a{};
    for (int i = 0; i < 31; ++i) a.in[i] = (const float*)d_in[i];
    a.out = (float*)d_out; a.ws = (unsigned char*)d_ws;
    if (MK_N_LAUNCHES == 1) { a.ph_lo = 0; a.ph_hi = N_PHASES; hipLaunchKernelGGL(fwd_kernel, dim3(GRID), dim3(NTHR), LDS_BYTES, stream, a); }
    else { for (int p = 0; p < N_PHASES; ++p) { a.ph_lo = p; a.ph_hi = p + 1; hipLaunchKernelGGL(fwd_kernel, dim3(GRID), dim3(NTHR), LDS_BYTES, stream, a); } }
    const hipError_t le = hipPeekAtLastError();
    if (le != hipSuccess) fprintf(stderr, "kernel_launch: launch failed: %s\n", hipGetErrorName(le));
}
```

```cpp
#include <hip/hip_runtime.h>
#include <cstdio>
#include <cstdint>

#ifndef MK_N_LAUNCHES
#define MK_N_LAUNCHES 1
#endif

namespace pg8 {
#define PG8_LAS __attribute__((address_space(3)))
typedef unsigned short bf16_t;
typedef short bf16x8 __attribute__((ext_vector_type(8)));
typedef float f32x4 __attribute__((ext_vector_type(4)));
typedef unsigned u32x4 __attribute__((ext_vector_type(4)));
typedef unsigned u32x2 __attribute__((ext_vector_type(2)));
constexpr int BM = 256, BK = 64, HALF = 128, HTB = HALF * BK * 2  , STAGE_BYTES = 8 * HTB, NXCD = 8, WGM = 8;

__host__ __device__ __forceinline__ int lds_byte(int r, int c) { const int st = (r >> 4) * 2 + (c >> 5), rr = r & 15, cc = c & 31, ob = rr * 64 + cc * 2; return st * 1024 + (ob ^ (((ob >> 9) & 1) << 5)); }
__host__ __device__ __forceinline__ void stage_rc(int b, int& R, int& C) { const int st = b / 1024, sb = b % 1024, swz = sb ^ (((sb >> 9) & 1) << 5); R = (st >> 1) * 16 + swz / 64; C = (st & 1) * 32 + (swz % 64) / 2; }
__host__ __device__ __forceinline__ int perm32(int rho) { const int n = rho >> 4, i = rho & 15; return 8 * (i >> 2) + 4 * n + (i & 3); }

struct Unit { int pm, pn, ka, kb, ui, ks; };
struct Gemm { const bf16_t* A; const bf16_t* Bt; int lda, ldb, K; };

struct StaticOrder {
    int nM, nN, nwg, G, c;
    __host__ __device__ void init(int M, int N, int G_, int c_) { nM = M / BM; nN = N / BM; nwg = nM * nN; G = G_; c = c_; }
    __host__ __device__ bool next(int i, Unit& u) const {
        const long L = (long)i * G + c; if (L >= nwg) return false;
        int wgid = (int)L; { const int q = nwg / NXCD, r = nwg % NXCD, xcd = wgid % NXCD, off = wgid / NXCD; wgid = (xcd < r ? xcd * (q + 1) : r * (q + 1) + (xcd - r) * q) + off; }
        const int nig = WGM * nN, gid = wgid / nig, fm = gid * WGM, gsz = (nM - fm) < WGM ? (nM - fm) : WGM;
        u.pm = fm + ((wgid % nig) % gsz); u.pn = (wgid % nig) / gsz; u.ka = 0; u.kb = 0; u.ui = i; u.ks = 0; return true;
    }
    __device__ __forceinline__ void a_ready(const Unit&) const {}
    __device__ __forceinline__ void done(const Unit&) const {}
};
struct HeadOrder {
    int nM, nH, nwg, G, c, K;
    __host__ __device__ void init(int M, int nH_, int K_, int G_, int c_) { nM = M / BM; nH = nH_; nwg = nM * nH; G = G_; c = c_; K = K_; }
    __host__ __device__ bool next(int i, Unit& u) const {
        const long L = (long)i * G + c; if (L >= nwg) return false;
        u.pm = (int)(L % nM); u.pn = (int)(L / nM); u.ka = u.pn * K; u.kb = 0; u.ui = i; u.ks = 0; return true;
    }
    __device__ __forceinline__ void a_ready(const Unit&) const {}
    __device__ __forceinline__ void done(const Unit&) const {}
};

struct SplitOrder {
    int nN, S, Kc, nwg, G, c;
    __host__ __device__ void init(int nM, int nN_, int S_, int Kc_, int G_, int c_) { nN = nN_; S = S_; Kc = Kc_; nwg = nM * nN_ * S_; G = G_; c = c_; }
    __host__ __device__ bool next(int i, Unit& u) const {
        const long L = (long)i * G + c; if (L >= nwg) return false;
        const int per = S * nN, rem = (int)(L % per); u.pm = (int)(L / per); u.pn = rem / S; u.ks = rem % S; u.ka = u.ks * Kc; u.kb = u.ka; u.ui = i; return true;
    }
    __device__ __forceinline__ void a_ready(const Unit&) const {}
    __device__ __forceinline__ void done(const Unit&) const {}
};
__device__ __forceinline__ unsigned cvt_pk_bf16(float lo, float hi) { unsigned r; asm volatile("v_cvt_pk_bf16_f32 %0, %1, %2" : "=v"(r) : "v"(lo), "v"(hi)); return r; }

template <int ACT> struct EpiScale {
    static constexpr bool PERM = true, AFTER_DRAIN = false;
    bf16_t* O; int ldc; const PG8_LAS float* rs;
    __device__ __forceinline__ void operator()(const f32x4 (&acc)[2][2][4][2], const Unit& u, int wr, int wc, int fr, int fq) const {
        const int row0 = u.pm * BM + wr * 64 + fr, col0 = u.pn * BM + wc * 32 + 8 * fq;
        const PG8_LAS float* rt = rs + u.ui * 256 + wr * 64 + fr;
#pragma unroll
        for (int ai = 0; ai < 2; ++ai)
#pragma unroll
            for (int m = 0; m < 4; ++m) { bf16_t* rowp = O + (size_t)(row0 + ai * HALF + m * 16) * ldc + col0; const float s = rt[ai * HALF + m * 16];
#pragma unroll
                for (int bj = 0; bj < 2; ++bj) { f32x4 v0 = acc[ai][bj][m][0] * s, v1 = acc[ai][bj][m][1] * s;
                    if (ACT == 1) {
#pragma unroll
                        for (int e = 0; e < 4; ++e) { const float a = fmaxf(v0[e], 0.f), b = fmaxf(v1[e], 0.f); v0[e] = a * a; v1[e] = b * b; } }
                    u32x4 w; w.x = cvt_pk_bf16(v0[0], v0[1]); w.y = cvt_pk_bf16(v0[2], v0[3]); w.z = cvt_pk_bf16(v1[0], v1[1]); w.w = cvt_pk_bf16(v1[2], v1[3]);
                    *(u32x4*)(rowp + bj * HALF) = w; } }
    }
};
template <bool FINAL> struct EpiResid {
    static constexpr bool PERM = true, AFTER_DRAIN = false;
    const bf16_t* xb; bf16_t* xbo; float* out; float* ssq; int ldc;
    __device__ __forceinline__ void operator()(const f32x4 (&acc)[2][2][4][2], const Unit& u, int wr, int wc, int fr, int fq) const {
        const int col0 = u.pn * BM + wc * 32 + 8 * fq;
        u32x4 xin[2][4][2];
#pragma unroll
        for (int ai = 0; ai < 2; ++ai)
#pragma unroll
            for (int m = 0; m < 4; ++m)
#pragma unroll
                for (int bj = 0; bj < 2; ++bj) xin[ai][m][bj] = *(const u32x4*)(xb + (size_t)(u.pm * BM + ai * HALF + wr * 64 + m * 16 + fr) * ldc + col0 + bj * HALF);
#pragma unroll
        for (int ai = 0; ai < 2; ++ai)
#pragma unroll
            for (int m = 0; m < 4; ++m) { const int row = u.pm * BM + ai * HALF + wr * 64 + m * 16 + fr; float q = 0.f;
#pragma unroll
                for (int bj = 0; bj < 2; ++bj) { const size_t o = (size_t)row * ldc + col0 + bj * HALF;
                    const u32x4 xi = xin[ai][m][bj];
                    f32x4 v0 = acc[ai][bj][m][0], v1 = acc[ai][bj][m][1];
                    v0[0] += __builtin_bit_cast(float, xi.x << 16); v0[1] += __builtin_bit_cast(float, xi.x & 0xffff0000u); v0[2] += __builtin_bit_cast(float, xi.y << 16); v0[3] += __builtin_bit_cast(float, xi.y & 0xffff0000u);
                    v1[0] += __builtin_bit_cast(float, xi.z << 16); v1[1] += __builtin_bit_cast(float, xi.z & 0xffff0000u); v1[2] += __builtin_bit_cast(float, xi.w << 16); v1[3] += __builtin_bit_cast(float, xi.w & 0xffff0000u);
                    if (FINAL) { *(f32x4*)(out + o) = v0; *(f32x4*)(out + o + 4) = v1; }
                    else { u32x4 w; w.x = cvt_pk_bf16(v0[0], v0[1]); w.y = cvt_pk_bf16(v0[2], v0[3]); w.z = cvt_pk_bf16(v1[0], v1[1]); w.w = cvt_pk_bf16(v1[2], v1[3]); *(u32x4*)(xbo + o) = w;
                        q += ((v0[0] * v0[0] + v0[1] * v0[1]) + (v0[2] * v0[2] + v0[3] * v0[3])) + ((v1[0] * v1[0] + v1[1] * v1[1]) + (v1[2] * v1[2] + v1[3] * v1[3])); } }
                if (!FINAL) { q += __shfl_xor(q, 16); q += __shfl_xor(q, 32);
                    if (fq == 0) ssq[(size_t)row * 64 + u.pn * 4 + wc] = q; } }
    }
};
struct EpiPartial {
    static constexpr bool PERM = false, AFTER_DRAIN = false;
    float* P; int ldp, ncols, mrows; const PG8_LAS float* rs;
    __device__ __forceinline__ void operator()(const f32x4 (&acc)[2][2][4][2], const Unit& u, int wr, int wc, int fr, int fq) const {
        const int col0 = u.pn * BM + wc * 32 + 4 * fq; const PG8_LAS float* rt = rs + u.ui * 256 + wr * 64 + fr;
#pragma unroll
        for (int ai = 0; ai < 2; ++ai)
#pragma unroll
            for (int m = 0; m < 4; ++m) { const int row = u.pm * BM + ai * HALF + wr * 64 + m * 16 + fr; const float sc = rt[ai * HALF + m * 16];
                float* rp = P + ((size_t)u.ks * mrows + row) * ldp;
#pragma unroll
                for (int bj = 0; bj < 2; ++bj)
#pragma unroll
                    for (int n = 0; n < 2; ++n) { const int c = col0 + bj * HALF + 16 * n; if (c < ncols) *(f32x4*)(rp + c) = acc[ai][bj][m][n] * sc; } }
    }
};
struct EpiLora {
    static constexpr bool PERM = true, AFTER_DRAIN = false;
    bf16_t* O; int ldc; const float* bias; int kind;
    __device__ __forceinline__ void operator()(const f32x4 (&acc)[2][2][4][2], const Unit& u, int wr, int wc, int fr, int fq) const {
        const int col0 = u.pn * BM + wc * 32 + 8 * fq;
#pragma unroll
        for (int bj = 0; bj < 2; ++bj) { const int c = col0 + bj * HALF; f32x4 b0 = (f32x4){0.f, 0.f, 0.f, 0.f}, b1 = b0; if (kind != 2) { b0 = *(const f32x4*)(bias + c); b1 = *(const f32x4*)(bias + c + 4); }
#pragma unroll
            for (int ai = 0; ai < 2; ++ai)
#pragma unroll
                for (int m = 0; m < 4; ++m) { const int row = u.pm * BM + ai * HALF + wr * 64 + m * 16 + fr; f32x4 v0 = acc[ai][bj][m][0] + b0, v1 = acc[ai][bj][m][1] + b1;
                    if (kind == 0) {
#pragma unroll
                        for (int e = 0; e < 4; ++e) { float x = -v0[e]; float sp = fmaxf(x, 0.f) + 0.6931471805599453f * __builtin_amdgcn_logf(1.f + __builtin_amdgcn_exp2f(-1.4426950408889634f * fabsf(x))); v0[e] = -1.4426950408889634f * __builtin_amdgcn_exp2f(-1.4426950408889634f * (sp + 0.5f));
                            x = -v1[e]; sp = fmaxf(x, 0.f) + 0.6931471805599453f * __builtin_amdgcn_logf(1.f + __builtin_amdgcn_exp2f(-1.4426950408889634f * fabsf(x))); v1[e] = -1.4426950408889634f * __builtin_amdgcn_exp2f(-1.4426950408889634f * (sp + 0.5f)); } }
                    else if (kind == 1) {
#pragma unroll
                        for (int e = 0; e < 4; ++e) { v0[e] = __builtin_amdgcn_rcpf(1.f + __builtin_amdgcn_exp2f(-1.4426950408889634f * v0[e])); v1[e] = __builtin_amdgcn_rcpf(1.f + __builtin_amdgcn_exp2f(-1.4426950408889634f * v1[e])); } }
                    u32x4 w; w.x = cvt_pk_bf16(v0[0], v0[1]); w.y = cvt_pk_bf16(v0[2], v0[3]); w.z = cvt_pk_bf16(v1[0], v1[1]); w.w = cvt_pk_bf16(v1[2], v1[3]);
                    *(u32x4*)(O + (size_t)row * ldc + c) = w; } }
    }
};


template <class Epi, class Sched, bool ALIGN_EPI = false, bool SP2 = false>
__device__ __forceinline__ void gemm_phase(PG8_LAS unsigned char* lds, const Gemm g, const Sched& S, const Epi& E) {
    const int tid = threadIdx.x, wid = __builtin_amdgcn_readfirstlane(tid >> 6), lane = tid & 63, wr = wid >> 2, wc = wid & 3, fr = lane & 15, fq = lane >> 4;
    const int K = g.K, nt = K / BK, lda = g.lda, ldb = g.ldb;
    unsigned voffA[2], voffB[2];
#pragma unroll
    for (int i = 0; i < 2; ++i) { int R, C; stage_rc(tid * 16 + i * 8192, R, C); const int Rb = Epi::PERM ? ((R & ~31) + perm32(R & 31)) : R;
        voffA[i] = (unsigned)(R * lda + C) * 2u; voffB[i] = (unsigned)(Rb * ldb + C) * 2u; }
    const size_t kstep = (size_t)(BK * 2);
    const size_t hstepA = (size_t)HALF * lda * 2, hstepB = (size_t)HALF * ldb * 2;
    const size_t tstepA = 2 * hstepA, tstepB = 2 * hstepB;
    const unsigned ldsw = (unsigned)wid * 1024u;
    const int aoff = lds_byte(wr * 64 + fr, fq * 8), boff = lds_byte(wc * 32 + fr, fq * 8);
#define PG8_SA(b, h) (((b) * 2 + (h)) * HTB)
#define PG8_SB(b, h) ((4 + (b) * 2 + (h)) * HTB)
#define PG8_STAGE(bufoff, gbase, voff) do { _Pragma("unroll") for (int _i = 0; _i < 2; ++_i) \
        __builtin_amdgcn_global_load_lds((const unsigned*)((const char*)(gbase) + (voff)[_i]), (PG8_LAS unsigned*)(lds + (bufoff) + ldsw + _i * 8192), 16, 0, 0); } while (0)
#define PG8_LDA(dst, b, h) do { _Pragma("unroll") for (int m = 0; m < 4; ++m) _Pragma("unroll") for (int k = 0; k < 2; ++k) dst[m][k] = *(const PG8_LAS bf16x8*)(lds + PG8_SA(b, h) + aoff + m * 2048 + k * 1024); } while (0)
#define PG8_LDB(dst, b, h) do { _Pragma("unroll") for (int n = 0; n < 2; ++n) _Pragma("unroll") for (int k = 0; k < 2; ++k) dst[n][k] = *(const PG8_LAS bf16x8*)(lds + PG8_SB(b, h) + boff + n * 2048 + k * 1024); } while (0)
#define PG8_MMA(ai, bj, At, Bt) do { __builtin_amdgcn_s_setprio(1); _Pragma("unroll") for (int m = 0; m < 4; ++m) _Pragma("unroll") for (int n = 0; n < 2; ++n) _Pragma("unroll") for (int k = 0; k < 2; ++k) \
        acc[ai][bj][m][n] = __builtin_amdgcn_mfma_f32_16x16x32_bf16(Bt[n][k], At[m][k], acc[ai][bj][m][n], 0, 0, 0); __builtin_amdgcn_s_setprio(0); } while (0)
#define PG8_WAIT_V(n) asm volatile("s_waitcnt vmcnt(" #n ")" ::: "memory")
#define PG8_WAIT_L(n) asm volatile("s_waitcnt lgkmcnt(" #n ")" ::: "memory")
#define PG8_BAR __builtin_amdgcn_s_barrier()
#define PG8_SCHED __builtin_amdgcn_sched_barrier(0)
    Unit cur, nxt; int ui = 0;
    if (!S.next(0, cur)) return;
    f32x4 acc[2][2][4][2];
#pragma unroll
    for (int a = 0; a < 2; ++a)
#pragma unroll
        for (int b = 0; b < 2; ++b)
#pragma unroll
            for (int m = 0; m < 4; ++m)
#pragma unroll
                for (int n = 0; n < 2; ++n) acc[a][b][m][n] = (f32x4){0.f, 0.f, 0.f, 0.f};
    bf16x8 At[4][2], B0[2][2], B1[2][2];
    const char* cA = (const char*)g.A + (size_t)cur.pm * tstepA + (size_t)cur.ka * 2; const char* cB = (const char*)g.Bt + (size_t)cur.pn * tstepB + (size_t)cur.kb * 2;
    S.a_ready(cur);
    if constexpr (SP2) {
        PG8_STAGE(PG8_SB(0, 0), cB, voffB); PG8_STAGE(PG8_SB(0, 1), cB + hstepB, voffB); PG8_STAGE(PG8_SA(0, 0), cA, voffA); PG8_STAGE(PG8_SA(0, 1), cA + hstepA, voffA);
        if (wr == 1) PG8_BAR;
        PG8_WAIT_V(2); PG8_BAR;
        PG8_STAGE(PG8_SB(1, 0), cB + kstep, voffB); PG8_STAGE(PG8_SA(1, 0), cA + kstep, voffA); PG8_STAGE(PG8_SB(1, 1), cB + hstepB + kstep, voffB);
        PG8_WAIT_V(6); PG8_BAR;
    } else {
        PG8_STAGE(PG8_SB(0, 0), cB, voffB); PG8_STAGE(PG8_SA(0, 0), cA, voffA); PG8_STAGE(PG8_SB(0, 1), cB + hstepB, voffB); PG8_STAGE(PG8_SA(0, 1), cA + hstepA, voffA);
        if (wr == 1) PG8_BAR;
        PG8_WAIT_V(4); PG8_BAR;
        PG8_STAGE(PG8_SB(1, 0), cB + kstep, voffB); PG8_STAGE(PG8_SA(1, 0), cA + kstep, voffA); PG8_STAGE(PG8_SB(1, 1), cB + hstepB + kstep, voffB);
        PG8_WAIT_V(6); PG8_BAR;
    }
    for (;;) {
        const bool has_next = S.next(ui + 1, nxt);
        const char* nA = has_next ? (const char*)g.A + (size_t)nxt.pm * tstepA + (size_t)nxt.ka * 2 : cA; const char* nB = has_next ? (const char*)g.Bt + (size_t)nxt.pn * tstepB + (size_t)nxt.kb * 2 : cB;
        for (int t = 0; t < nt; t += 2) {
            const bool last = (t == nt - 2);
            const char* a1 = cA + (size_t)(t + 1) * kstep;
            const char* a2 = last ? nA : cA + (size_t)(t + 2) * kstep; const char* b2 = last ? nB : cB + (size_t)(t + 2) * kstep;
            const char* a3 = a2 + kstep; const char* b3 = b2 + kstep;
            if (last && has_next) S.a_ready(nxt);
            if constexpr (SP2) {
            PG8_LDB(B0, 0, 0); PG8_LDB(B1, 0, 1); PG8_SCHED; PG8_LDA(At, 0, 0); PG8_STAGE(PG8_SA(1, 1), a1 + hstepA, voffA);
            PG8_WAIT_V(8); PG8_WAIT_L(0); PG8_BAR; PG8_MMA(0, 0, At, B0); PG8_MMA(0, 1, At, B1); PG8_BAR; PG8_SCHED;
            PG8_LDA(At, 0, 1); PG8_STAGE(PG8_SB(0, 0), b2, voffB); PG8_STAGE(PG8_SB(0, 1), b2 + hstepB, voffB); PG8_STAGE(PG8_SA(0, 0), a2, voffA);
            PG8_WAIT_V(8); PG8_WAIT_L(0); PG8_BAR; PG8_MMA(1, 0, At, B0); PG8_MMA(1, 1, At, B1); PG8_BAR; PG8_SCHED;
            PG8_LDB(B0, 1, 0); PG8_LDB(B1, 1, 1); PG8_SCHED; PG8_LDA(At, 1, 0); PG8_STAGE(PG8_SA(0, 1), a2 + hstepA, voffA);
            PG8_WAIT_V(8); PG8_WAIT_L(0); PG8_BAR; PG8_MMA(0, 0, At, B0); PG8_MMA(0, 1, At, B1); PG8_BAR; PG8_SCHED;
            PG8_LDA(At, 1, 1); PG8_STAGE(PG8_SB(1, 0), b3, voffB); PG8_STAGE(PG8_SB(1, 1), b3 + hstepB, voffB); PG8_STAGE(PG8_SA(1, 0), a3, voffA);
            PG8_WAIT_V(8); PG8_WAIT_L(0); PG8_BAR; PG8_MMA(1, 0, At, B0); PG8_MMA(1, 1, At, B1); PG8_BAR; PG8_SCHED;
            } else {
            PG8_LDB(B0, 0, 0); PG8_SCHED; PG8_LDA(At, 0, 0); PG8_STAGE(PG8_SA(1, 1), a1 + hstepA, voffA);
            PG8_WAIT_L(8); PG8_BAR; PG8_WAIT_L(0); PG8_MMA(0, 0, At, B0); PG8_BAR; PG8_SCHED;
            PG8_LDB(B1, 0, 1); PG8_STAGE(PG8_SB(0, 0), b2, voffB);
            PG8_BAR; PG8_WAIT_L(0); PG8_MMA(0, 1, At, B1); PG8_BAR;
            PG8_LDA(At, 0, 1); PG8_STAGE(PG8_SA(0, 0), a2, voffA);
            PG8_BAR; PG8_WAIT_L(0); PG8_MMA(1, 0, At, B0); PG8_BAR; PG8_SCHED;
            PG8_STAGE(PG8_SB(0, 1), b2 + hstepB, voffB);
            PG8_WAIT_V(6); PG8_BAR; PG8_MMA(1, 1, At, B1); PG8_BAR;
            PG8_LDB(B0, 1, 0); PG8_SCHED; PG8_LDA(At, 1, 0); PG8_STAGE(PG8_SA(0, 1), a2 + hstepA, voffA);
            PG8_WAIT_L(8); PG8_BAR; PG8_WAIT_L(0); PG8_MMA(0, 0, At, B0); PG8_BAR; PG8_SCHED;
            PG8_LDB(B1, 1, 1); PG8_STAGE(PG8_SB(1, 0), b3, voffB);
            PG8_BAR; PG8_WAIT_L(0); PG8_MMA(0, 1, At, B1); PG8_BAR;
            PG8_LDA(At, 1, 1); PG8_STAGE(PG8_SA(1, 0), a3, voffA);
            PG8_BAR; PG8_WAIT_L(0); PG8_MMA(1, 0, At, B0); PG8_BAR; PG8_SCHED;
            PG8_STAGE(PG8_SB(1, 1), b3 + hstepB, voffB);
            PG8_WAIT_V(6); PG8_BAR; PG8_MMA(1, 1, At, B1); PG8_BAR;
            }
        }
        if constexpr (ALIGN_EPI) { if (wr == 0) PG8_BAR; }
        if constexpr (!Epi::AFTER_DRAIN) { E(acc, cur, wr, wc, fr, fq); S.done(cur); }
        if (!has_next) break;
#pragma unroll
        for (int a = 0; a < 2; ++a)
#pragma unroll
            for (int b = 0; b < 2; ++b)
#pragma unroll
                for (int m = 0; m < 4; ++m)
#pragma unroll
                    for (int n = 0; n < 2; ++n) acc[a][b][m][n] = (f32x4){0.f, 0.f, 0.f, 0.f};
        cur = nxt; cA = nA; cB = nB; ++ui;
        if constexpr (ALIGN_EPI) { if (wr == 1) PG8_BAR; }
    }
    PG8_WAIT_V(0);
    if constexpr (!ALIGN_EPI) { if (wr == 0) PG8_BAR; }
    PG8_BAR;
    if constexpr (Epi::AFTER_DRAIN) { E.fused(acc, cur, wr, wc, fr, fq, lds, wid, lane); S.done(cur); }
#undef PG8_SA
#undef PG8_SB
#undef PG8_STAGE
#undef PG8_LDA
#undef PG8_LDB
#undef PG8_MMA
#undef PG8_WAIT_V
#undef PG8_WAIT_L
#undef PG8_BAR
#undef PG8_SCHED
}
}

constexpr int NWAVES = 8, NTHR = 512, GRID = 256;
constexpr int D = 4096, SEQ = 2048, NB = 4, M = NB * SEQ, FF = 4 * D;
constexpr int HY_IN = 10688, LDZ0 = 10752;
constexpr int ML_IN = 12304, LDZ1 = 12544;
constexpr int ZC_R = 4096, ZC_K = 6144, ZC_V = 8192, ZC_WL = 10240, ZC_AL = 10336, ZC_GL = 10432;
constexpr int MC_Q = 0, MC_K = 2048, MC_V = 4096, MC_O = 8192, MC_I = 12288, MC_F = 12296;
constexpr float NORM_EPS = 1e-6f, GN_EPS = 64e-5f;
constexpr int N_PHASES = 15;

constexpr size_t MiB = 1u << 20;
constexpr size_t WS_CTL = 0, CTL_ZERO_BYTES = 1 * MiB;
constexpr size_t WS_WHYIN = 1 * MiB;
constexpr size_t WS_WHYOUT = WS_WHYIN + (size_t)LDZ0 * D * 2;
constexpr size_t WS_WUP = WS_WHYOUT + (size_t)D * D * 2;
constexpr size_t WS_WDOWN = WS_WUP + 2 * (size_t)FF * D * 2;
constexpr size_t WS_WMLIN = WS_WDOWN + 2 * (size_t)FF * D * 2;
constexpr size_t WS_WMLOUT = WS_WMLIN + (size_t)LDZ1 * D * 2;
constexpr size_t WS_W2T = WS_WMLOUT + (size_t)D * D * 2;
constexpr size_t WS_A2T = WS_W2T + 2048 * 128 * 2;
constexpr size_t WS_G2T = WS_A2T + 2048 * 128 * 2;
constexpr size_t WS_WAT = WS_G2T + 2048 * 256 * 2;
constexpr size_t WS_WXT = WS_WAT + 256 * 2048 * 2;
constexpr size_t WS_XB = WS_WXT + 256 * 2048 * 2;
constexpr size_t WS_XF = WS_XB + (size_t)M * D * 2;
constexpr size_t WS_CAT = WS_XF + (size_t)M * D * 4;
constexpr size_t WS_SSQ = WS_CAT + (size_t)M * D * 2;
constexpr size_t WS_U = WS_SSQ + (size_t)M * 64 * 4;
constexpr size_t WS_Z = WS_U;
constexpr size_t WS_DEC = WS_U + (size_t)M * FF * 2;
constexpr size_t WS_AA = WS_DEC + (size_t)M * 2048 * 4;
constexpr size_t WS_GG = WS_AA + (size_t)M * 2048 * 4;
constexpr size_t WS_AW = WS_GG + (size_t)M * 2048 * 4;
constexpr size_t WS_AAL = WS_AW + (size_t)M * 128 * 2;
constexpr size_t WS_AG = WS_AAL + (size_t)M * 128 * 2;
constexpr size_t WS_HRAW = WS_DEC;
constexpr size_t WS_HSSQ = WS_GG;
constexpr size_t WS_ZP = WS_AG + (size_t)M * 256 * 2;
constexpr size_t WS_END = WS_ZP + 8 * (size_t)M * 16 * 4;
static_assert((size_t)M * LDZ1 * 2 <= (size_t)M * FF * 2, "Z fits in U's region");
static_assert(WS_HRAW + (size_t)M * D * 4 <= WS_GG, "HRAW fits in DEC|AA");
constexpr int CW_BAR = 4096;

constexpr int RING_BYTES = 131072;
constexpr int RS_OFF = RING_BYTES, RS_BYTES = 8192;
constexpr int LDSCTL_OFF = RS_OFF + RS_BYTES, MISC_OFF = LDSCTL_OFF + 320;
constexpr int LDS_BYTES = 147456;
static_assert(MISC_OFF + 128 <= LDS_BYTES, "LDS map");

#define GAS __attribute__((address_space(1)))
#define LAS __attribute__((address_space(3)))
typedef unsigned short bf16;
typedef unsigned v4u __attribute__((ext_vector_type(4)));
typedef unsigned v2u __attribute__((ext_vector_type(2)));
typedef float f32x4 __attribute__((ext_vector_type(4)));
typedef float f32x2 __attribute__((ext_vector_type(2)));
typedef GAS unsigned gu32;
#define RLX_AGENT __ATOMIC_RELAXED, __HIP_MEMORY_SCOPE_AGENT
#define LDS_WAIT() asm volatile("s_waitcnt lgkmcnt(0)" ::: "memory")
#define VM_WAIT() asm volatile("s_waitcnt vmcnt(0)" ::: "memory")
typedef __bf16 hwbf2_t __attribute__((ext_vector_type(2)));
__device__ __forceinline__ unsigned pk2(float lo, float hi) { const f32x2 v = {lo, hi}; return __builtin_bit_cast(unsigned, __builtin_convertvector(v, hwbf2_t)); }
__device__ __forceinline__ unsigned f2bf(float f) { return (unsigned)__builtin_bit_cast(unsigned short, (__bf16)f); }
__device__ __forceinline__ float bflo(unsigned w) { return __builtin_bit_cast(float, w << 16); }
__device__ __forceinline__ float bfhi(unsigned w) { return __builtin_bit_cast(float, w & 0xffff0000u); }
__device__ __forceinline__ float bf2f(bf16 h) { return __builtin_bit_cast(float, (unsigned)h << 16); }
__device__ __forceinline__ float sigmoidf_(float x) { return 1.f / (1.f + expf(-x)); }
__device__ __forceinline__ float fexp2(float x) { return __builtin_amdgcn_exp2f(x); }
__device__ __forceinline__ float fexp(float x) { return __builtin_amdgcn_exp2f(x * 1.4426950408889634f); }
__device__ __forceinline__ float frcp(float x) { return __builtin_amdgcn_rcpf(x); }
__device__ __forceinline__ float fsigmoid(float x) { return __builtin_amdgcn_rcpf(1.f + __builtin_amdgcn_exp2f(-1.4426950408889634f * x)); }
__device__ __forceinline__ float ftanh(float x) { return 1.f - 2.f * __builtin_amdgcn_rcpf(1.f + __builtin_amdgcn_exp2f(2.8853900817779268f * x)); }
__device__ __forceinline__ float flogsig(float x) {
    const float e = fexp2(-1.4426950408889634f * fabsf(x)), u = 1.f + e, d = u - 1.f;
    const float l = (d == 0.f) ? e : 0.6931471805599453f * __builtin_amdgcn_logf(u) * (e * frcp(d));
    return fminf(x, 0.f) - l;
}
template <int CTRL, int RM> __device__ __forceinline__ float dpp_id(float idv, float v) { return __builtin_bit_cast(float, __builtin_amdgcn_update_dpp(__builtin_bit_cast(int, idv), __builtin_bit_cast(int, v), CTRL, RM, 0xF, false)); }
__device__ __forceinline__ float scan_add64(float v) {
    v += dpp_id<0x111, 0xF>(0.f, v); v += dpp_id<0x112, 0xF>(0.f, v); v += dpp_id<0x114, 0xF>(0.f, v); v += dpp_id<0x118, 0xF>(0.f, v);
    v += dpp_id<0x142, 0xA>(0.f, v); v += dpp_id<0x143, 0xC>(0.f, v); return v; }
__device__ __forceinline__ float scan_max64(float v) { const float ni = -3.0e38f;
    v = fmaxf(v, dpp_id<0x111, 0xF>(ni, v)); v = fmaxf(v, dpp_id<0x112, 0xF>(ni, v)); v = fmaxf(v, dpp_id<0x114, 0xF>(ni, v)); v = fmaxf(v, dpp_id<0x118, 0xF>(ni, v));
    v = fmaxf(v, dpp_id<0x142, 0xA>(ni, v)); v = fmaxf(v, dpp_id<0x143, 0xC>(ni, v)); return v; }
__device__ __forceinline__ float lane63(float v) { return __builtin_bit_cast(float, __builtin_amdgcn_readlane(__builtin_bit_cast(int, v), 63)); }
__device__ __forceinline__ float fgelu_tanh(float x) { return 0.5f * x * (1.f + ftanh(0.7978845608028654f * (x + 0.044715f * x * x * x))); }
__device__ __forceinline__ float softplusf_(float x) { return fmaxf(x, 0.f) + log1pf(expf(-fabsf(x))); }
__device__ __forceinline__ float gelu_tanh(float x) { return 0.5f * x * (1.f + tanhf(0.7978845608028654f * (x + 0.044715f * x * x * x))); }
template <int CTRL> __device__ __forceinline__ float dpp_f(float v) { return __builtin_bit_cast(float, __builtin_amdgcn_update_dpp(0, __builtin_bit_cast(int, v), CTRL, 0xF, 0xF, false)); }
__device__ __forceinline__ float red4(float v) { v += dpp_f<0xB1>(v); v += dpp_f<0x4E>(v); return v; }
__device__ __forceinline__ float red8(float v) { v = red4(v); v += dpp_f<0x141>(v); return v; }
__device__ __forceinline__ float red16(float v) { v = red8(v); v += dpp_f<0x140>(v); return v; }


#define XB_TMO      128
#define XB_XCNT(j)  (256  + 64 * (j))
#define XB_XSUB(j)  (1280 + 64 * (j))
#define XB_XGEN(j)  (2304 + 64 * (j))
#define XB_TOP      3328
#define XB_TOPGEN   3392
#define XCD_BAR_WORDS 3456
#define XB_SPIN_CAP (1u << 18)

__device__ __forceinline__ unsigned xb_ld(unsigned* p)              { return __hip_atomic_load(p, __ATOMIC_RELAXED, __HIP_MEMORY_SCOPE_AGENT); }
__device__ __forceinline__ unsigned xb_add(unsigned* p, unsigned v) { return __hip_atomic_fetch_add(p, v, __ATOMIC_RELAXED, __HIP_MEMORY_SCOPE_AGENT); }
__device__ __forceinline__ unsigned xb_xcc_id() { return (unsigned)__builtin_amdgcn_s_getreg((3 << 11) | 20) & 0xFu; }
#define XB_SPIN(cond, bar) do { unsigned _sp = 0; while (cond) { __builtin_amdgcn_s_sleep(1); \
    if ((++_sp & 255u) == 0u) { if (xb_ld(&(bar)[XB_TMO])) break; if (_sp > XB_SPIN_CAP) { atomicAdd(&(bar)[XB_TMO], 1u); break; } } } } while (0)

struct XcdBarrier {
    unsigned* bar; unsigned x;
    volatile LAS unsigned* st;
};

__device__ __forceinline__ XcdBarrier xcd_barrier_post(unsigned* bar, volatile LAS unsigned* st) {
    XcdBarrier b; b.bar = bar; b.x = xb_xcc_id(); b.st = st;
    if (threadIdx.x == 0) (void)xb_add(&bar[XB_XCNT(b.x)], 1u);
    return b;
}
__device__ __forceinline__ void xcd_barrier_complete(unsigned* bar, unsigned x, unsigned& nloc, unsigned& nx) {
    const unsigned G = gridDim.x * gridDim.y * gridDim.z;
    unsigned sum, cnt, mine, sp = 0u;
    for (;;) {
        sum = 0u; cnt = 0u; mine = 0u;
#pragma unroll
        for (unsigned j = 0; j < 16; ++j) { const unsigned c = xb_ld(&bar[XB_XCNT(j)]); sum += c; cnt += (c > 0u) ? 1u : 0u; mine = (j == x) ? c : mine; }
        if (sum == G) break;
        __builtin_amdgcn_s_sleep(1);
        if ((++sp & 255u) == 0u) { if (xb_ld(&bar[XB_TMO])) break; if (sp > XB_SPIN_CAP) { atomicAdd(&bar[XB_TMO], 1u); break; } }
    }
    nloc = mine > 0u ? mine : 1u; nx = cnt > 0u ? cnt : 1u;
}

__device__ __forceinline__ void xcd_barrier(const XcdBarrier& b) {
    asm volatile("s_waitcnt vmcnt(0)" ::: "memory");
    __syncthreads();
    if (threadIdx.x == 0) {
        unsigned* bar = b.bar;
        __builtin_amdgcn_s_waitcnt(0);
        unsigned nloc = b.st[0], nx = b.st[1];
        if (nloc == 0u) { xcd_barrier_complete(bar, b.x, nloc, nx); b.st[0] = nloc; b.st[1] = nx; }
        const unsigned old = xb_add(&bar[XB_XSUB(b.x)], 1u);
        const unsigned gen = old / nloc;
        if (old + 1u == (gen + 1u) * nloc) {
            __builtin_amdgcn_fence(__ATOMIC_RELEASE, "agent");
            asm volatile("s_waitcnt vmcnt(0)" ::: "memory");
            const unsigned og = xb_add(&bar[XB_TOP], 1u);
            const unsigned tg = og / nx;
            if (og + 1u == (tg + 1u) * nx) xb_add(&bar[XB_TOPGEN], 1u);
            else XB_SPIN(xb_ld(&bar[XB_TOPGEN]) == tg, bar);
            __builtin_amdgcn_fence(__ATOMIC_ACQUIRE, "agent");
            xb_add(&bar[XB_XGEN(b.x)], 1u);
            asm volatile("s_waitcnt vmcnt(0)" ::: "memory");
        } else {
            XB_SPIN(xb_ld(&bar[XB_XGEN(b.x)]) == gen, bar);
            __builtin_amdgcn_fence(__ATOMIC_ACQUIRE, "agent");
            asm volatile("s_waitcnt vmcnt(0)" ::: "memory");
        }
    }
    __syncthreads();
}


struct Args { const float* in[31]; float* out; unsigned char* ws; int ph_lo, ph_hi; };
#define CAS __attribute__((address_space(4)))
enum { I_X = 0, I_NMIX, I_NMLP, I_NFIN, I_UP, I_DOWN, I_HYIN, I_CONVW, I_CONVB, I_WA, I_BA, I_WX, I_BX, I_LAM, I_MU, I_W0, I_W2, I_A0, I_A2, I_G2, I_KK, I_KA, I_RK,
       I_LNW, I_LNB, I_HYOUT, I_MLIN, I_BI, I_BF, I_MLNORM, I_MLOUT };

__device__ __forceinline__ float wave_sum(float v) {
#pragma unroll
    for (int o = 1; o < 64; o <<= 1) v += __shfl_xor(v, o);
    return v;
}

__device__ __forceinline__ void conv_item(const float* W, int K, int N, bf16* WT, int ldk, const float* gain, LAS float* scr, int kt, int ntile, int lane) {
    const int k0 = kt * 64, n0 = ntile * 64, nl = (lane & 15) * 4, n = n0 + nl;
    f32x4 v[16]; float gv[16];
#pragma unroll
    for (int i = 0; i < 16; ++i) { const int k = k0 + i * 4 + (lane >> 4); v[i] = (f32x4){0.f, 0.f, 0.f, 0.f}; gv[i] = 1.f;
        if (k < K && n < N) { v[i] = __builtin_nontemporal_load((const f32x4*)(W + (size_t)k * N + n)); if (gain) gv[i] = gain[k]; } }
#pragma unroll
    for (int i = 0; i < 16; ++i) { const int kl = i * 4 + (lane >> 4); const f32x4 x = v[i] * gv[i];
        LAS float* s = scr + kl * 65 + nl; s[0] = x.x; s[1] = x.y; s[2] = x.z; s[3] = x.w; }
    LDS_WAIT(); asm volatile("" ::: "memory");
    const int c = lane & 7;
#pragma unroll
    for (int j = 0; j < 8; ++j) { const int r = j * 8 + (lane >> 3); const LAS float* s = scr + (8 * c) * 65 + r;
        v4u o; o.x = pk2(s[0], s[65]); o.y = pk2(s[130], s[195]); o.z = pk2(s[260], s[325]); o.w = pk2(s[390], s[455]);
        *(GAS v4u*)(WT + (size_t)(n0 + r) * ldk + k0 + 8 * c) = o; }
    LDS_WAIT(); asm volatile("" ::: "memory");
}
constexpr int CONV_TOTAL = 32 * 2 + 32 * 2 + 32 * 4 + 2 * 4 * 32 + (LDZ0 / 64) * 64 + 64 * 64 + (FF / 64) * 64 + 64 * (FF / 64) + (LDZ1 / 64) * 64 + 64 * 64 + 64 * (FF / 64) + (FF / 64) * 64;
constexpr int CONV_P9 = 36864, CONV_P4 = 16384;
constexpr int G1_WGS = 224;
constexpr int CONV_P1 = 26624;
constexpr int CONV_A = CONV_TOTAL - CONV_P9 - CONV_P4, CONV_B = CONV_TOTAL - CONV_P9, CONV_A0 = CONV_A - CONV_P1;
static_assert(CONV_A0 >= 32 * 2 + 32 * 2 + 32 * 4 + 2 * 4 * 32 + (LDZ0 / 64) * 64, "the layer-0 projection weights are converted in the prologue");
static_assert(CONV_P9 <= 2 * 64 * (FF / 64) + 64 * 64 && CONV_P9 + CONV_P4 <= 3 * 64 * (FF / 64) + 64 * 64, "deferred ranges: mLSTM-phase items are layer-1 output / MLP weights; RG-LRU-phase items are needed after phase 4 (layer-0 down, layer-1 weights)");
__device__ __forceinline__ void conv_range(LAS unsigned char* lds, const CAS Args* a, int first, int last, int gw, int ngw, int wave, int lane) {
    unsigned char* ws = a->ws;
    LAS float* scr = (LAS float*)(lds + wave * 16640);
#define CONV(Wp, K_, N_, NPAD_, WTp, LDK_, GAIN_) { constexpr int ntn = (NPAD_) / 64, cnt = ntn * ((LDK_) / 64); \
        if (r < cnt) { conv_item(Wp, K_, N_, (bf16*)(WTp), LDK_, GAIN_, scr, r / ntn, r % ntn, lane); continue; } r -= cnt; }
    for (int it = first + gw; it < last; it += ngw) {
        int r = it;
        CONV(a->in[I_W2], 96, 2048, 2048, ws + WS_W2T, 128, (const float*)nullptr)
        CONV(a->in[I_A2], 96, 2048, 2048, ws + WS_A2T, 128, (const float*)nullptr)
        CONV(a->in[I_G2], 256, 2048, 2048, ws + WS_G2T, 256, (const float*)nullptr)
        CONV(a->in[I_WA], 2048, 256, 256, ws + WS_WAT, 2048, (const float*)nullptr)
        CONV(a->in[I_WX], 2048, 256, 256, ws + WS_WXT, 2048, (const float*)nullptr)
        CONV(a->in[I_HYIN], D, HY_IN, LDZ0, ws + WS_WHYIN, D, a->in[I_NMIX])
        CONV(a->in[I_HYOUT], D, D, D, ws + WS_WHYOUT, D, (const float*)nullptr)
        CONV(a->in[I_UP], D, FF, FF, ws + WS_WUP, D, a->in[I_NMLP])
        CONV(a->in[I_MLIN], D, ML_IN, LDZ1, ws + WS_WMLIN, D, a->in[I_NMIX] + D)
        CONV(a->in[I_DOWN], FF, D, D, ws + WS_WDOWN, FF, (const float*)nullptr)
        CONV(a->in[I_MLOUT], D, D, D, ws + WS_WMLOUT, D, (const float*)nullptr)
        CONV(a->in[I_DOWN] + (size_t)D * FF, FF, D, D, ws + WS_WDOWN + (size_t)FF * D * 2, FF, (const float*)nullptr)
        CONV(a->in[I_UP] + (size_t)D * FF, D, FF, FF, ws + WS_WUP + (size_t)FF * D * 2, D, a->in[I_NMLP] + D)
    }
#undef CONV
}
constexpr int CQ_BATCH = 64, CW_QUEUE = 16384;
__device__ __forceinline__ void conv_queue(LAS unsigned char* lds, const CAS Args* a, int first, int last, int q, int tid) {
    volatile LAS int* slot = (volatile LAS int*)(lds + MISC_OFF + 64);
    unsigned* ctr = (unsigned*)(a->ws + WS_CTL) + CW_QUEUE + 64 * q;
    const int wave = __builtin_amdgcn_readfirstlane(tid >> 6), lane = tid & 63;
    unsigned nxt = 0u;
    if (tid == 0) nxt = __hip_atomic_fetch_add(ctr, (unsigned)CQ_BATCH, __ATOMIC_RELAXED, __HIP_MEMORY_SCOPE_AGENT);
    __syncthreads();
    for (int it = 0;; ++it) {
        if (tid == 0) { slot[it & 1] = (int)nxt; nxt = __hip_atomic_fetch_add(ctr, (unsigned)CQ_BATCH, __ATOMIC_RELAXED, __HIP_MEMORY_SCOPE_AGENT); }
        LDS_WAIT(); __syncthreads();
        const int base = first + slot[it & 1];
        if (base >= last) break;
        conv_range(lds, a, base, (base + CQ_BATCH < last) ? base + CQ_BATCH : last, wave, NWAVES, wave, lane);
    }
}
__device__ __forceinline__ void p0_prologue(LAS unsigned char* lds, const CAS Args* a, int vcu, int wave, int lane) {
    unsigned char* ws = a->ws;
    const int gw = vcu * NWAVES + wave, NGW = GRID * NWAVES;
    conv_range(lds, a, 0, CONV_A0, gw, NGW, wave, lane);
    const float* x = a->in[I_X]; bf16* XB = (bf16*)(ws + WS_XB); float* SSQ = (float*)(ws + WS_SSQ);
    for (int m = gw; m < M; m += NGW) {
        const GAS f32x4* xr = (const GAS f32x4*)(x + (size_t)m * D) + lane; GAS v2u* o = (GAS v2u*)(XB + (size_t)m * D) + lane; float s = 0.f;
        f32x4 xv[16];
#pragma unroll
        for (int j = 0; j < 16; ++j) xv[j] = xr[64 * j];
#pragma unroll
        for (int j = 0; j < 16; ++j) { const f32x4 v = xv[j]; s += (v.x * v.x + v.y * v.y) + (v.z * v.z + v.w * v.w); v2u w; w.x = pk2(v.x, v.y); w.y = pk2(v.z, v.w); o[64 * j] = w; }
        s = wave_sum(s); if (lane == 0) SSQ[(size_t)m * 64] = s;
    }
}

template <class Sched> __device__ __forceinline__ void build_rs(LAS float* tab, const Sched& S, const float* ssq, int npart, int tid) {
    pg8::Unit u; int prev_pm = -1;
    for (int i = 0; i < 8 && S.next(i, u); ++i) {
        if (u.pm == prev_pm) { if ((tid & 1) == 0) tab[i * 256 + (tid >> 1)] = tab[(i - 1) * 256 + (tid >> 1)]; continue; }
        prev_pm = u.pm;
        const int row = u.pm * 256 + (tid >> 1), half = tid & 1; float s = 0.f;
        if (npart == 64) { const GAS f32x4* p = (const GAS f32x4*)(ssq + (size_t)row * 64 + half * 32);
#pragma unroll
            for (int k = 0; k < 8; ++k) { const f32x4 v = p[k]; s += (v.x + v.y) + (v.z + v.w); } }
        else if (half == 0) s = ((const GAS float*)ssq)[(size_t)row * 64];
        s += __shfl_xor(s, 1);
        if (half == 0) tab[i * 256 + (tid >> 1)] = 1.0f / sqrtf(s * (1.0f / D) + NORM_EPS);
    }
    LDS_WAIT(); __syncthreads();
}

typedef short s16x8_t __attribute__((ext_vector_type(8)));
typedef short s16x4_t __attribute__((ext_vector_type(4)));
#define MFMA16(a_, b_, c_) __builtin_amdgcn_mfma_f32_16x16x32_bf16(a_, b_, c_, 0, 0, 0)
__device__ __forceinline__ s16x4_t lds_tr4(const LAS bf16* p) { return __builtin_bit_cast(s16x4_t, __builtin_amdgcn_ds_read_tr16_b64_v4i16((LAS s16x4_t*)p)); }
__device__ __forceinline__ s16x8_t cat4(s16x4_t x, s16x4_t y) { return (s16x8_t){x[0], x[1], x[2], x[3], y[0], y[1], y[2], y[3]}; }
__device__ __forceinline__ void rwkv_prepass(const CAS Args* a, int gtid) {
    const bf16* Z = (const bf16*)(a->ws + WS_Z); bf16* AW = (bf16*)(a->ws + WS_AW); bf16* AAL = (bf16*)(a->ws + WS_AAL); bf16* AG = (bf16*)(a->ws + WS_AG);
    const float* mu = a->in[I_MU];
    static_assert(M * 64 == 4 * GRID * NTHR, "prepass: four tokens per thread");
    const int cg = gtid & 63, t0 = gtid >> 6;
    if (cg >= 56) { const int p = cg - 56;
#pragma unroll
        for (int k = 0; k < 4; ++k) { bf16* dst = (p < 4 ? AW : AAL) + (size_t)(t0 + 2048 * k) * 128 + 96 + (p & 3) * 8; *(GAS v4u*)dst = (v4u){0u, 0u, 0u, 0u}; } }
    else {
        const float* mp = mu + (ZC_WL - ZC_R) + cg * 8; const f32x4 m0 = *(const GAS f32x4*)mp, m1 = *(const GAS f32x4*)(mp + 4);
        const float mu8[8] = {m0[0], m0[1], m0[2], m0[3], m1[0], m1[1], m1[2], m1[3]};
        v4u zc[4], zp[4];
#pragma unroll
        for (int k = 0; k < 4; ++k) { const int t = t0 + 2048 * k; const bf16* zr = Z + (size_t)t * LDZ0 + ZC_WL + cg * 8;
            zc[k] = *(const GAS v4u*)zr; zp[k] = (v4u){0u, 0u, 0u, 0u}; if ((t & (SEQ - 1)) != 0) zp[k] = *(const GAS v4u*)(zr - LDZ0); }
#pragma unroll
        for (int k = 0; k < 4; ++k) { const int t = t0 + 2048 * k; float v[8];
#pragma unroll
            for (int e = 0; e < 4; ++e) { const float c0 = bflo(zc[k][e]), c1 = bfhi(zc[k][e]), p0 = bflo(zp[k][e]), p1 = bfhi(zp[k][e]);
                v[2 * e] = c0 + (p0 - c0) * mu8[2 * e]; v[2 * e + 1] = c1 + (p1 - c1) * mu8[2 * e + 1]; }
            bf16* dst;
            if (cg < 12) { dst = AW + (size_t)t * 128 + cg * 8;
#pragma unroll
                for (int e = 0; e < 8; ++e) v[e] = ftanh(v[e]); }
            else if (cg < 24) { dst = AAL + (size_t)t * 128 + (cg - 12) * 8; }
            else { dst = AG + (size_t)t * 256 + (cg - 24) * 8;
#pragma unroll
                for (int e = 0; e < 8; ++e) v[e] = fsigmoid(v[e]); }
            v4u o; o.x = pk2(v[0], v[1]); o.y = pk2(v[2], v[3]); o.z = pk2(v[4], v[5]); o.w = pk2(v[6], v[7]);
            *(GAS v4u*)dst = o; }
    }
}

struct RwkvRaw { v4u zr, zrp, zk, zkp, zv, zvp, d, a, g; };
__device__ __forceinline__ void rwkv_load(RwkvRaw& R, const bf16* Z, const bf16* DEC, const bf16* AAp, const bf16* GG, int b, int h, int j, int ltt, int lcc) {
    const int tpos = j * 64 + ltt; const size_t g = (size_t)b * SEQ + tpos; const int c0 = h * 64 + lcc * 8;
    const bf16* zrow = Z + g * LDZ0 + c0;
    R.zr = *(const GAS v4u*)(zrow + ZC_R); R.zk = *(const GAS v4u*)(zrow + ZC_K); R.zv = *(const GAS v4u*)(zrow + ZC_V);
    if (tpos > 0) { R.zrp = *(const GAS v4u*)(zrow + ZC_R - LDZ0); R.zkp = *(const GAS v4u*)(zrow + ZC_K - LDZ0); R.zvp = *(const GAS v4u*)(zrow + ZC_V - LDZ0); }
    else { R.zrp = (v4u){0u, 0u, 0u, 0u}; R.zkp = R.zrp; R.zvp = R.zrp; }
    R.d = *(const GAS v4u*)(DEC + g * 2048 + c0); R.a = *(const GAS v4u*)(AAp + g * 2048 + c0); R.g = *(const GAS v4u*)(GG + g * 2048 + c0);
}
constexpr int RW_TS = 72;
__device__ __forceinline__ v4u pack8(const float (&x)[8]) { v4u o; o.x = pk2(x[0], x[1]); o.y = pk2(x[2], x[3]); o.z = pk2(x[4], x[5]); o.w = pk2(x[6], x[7]); return o; }
__device__ __forceinline__ void rwkv_phase(LAS unsigned char* lds, const CAS Args* a, int bh, int tid) {
    LAS bf16* KAP = (LAS bf16*)lds; LAS bf16* RHAT = KAP + 64 * RW_TS; LAS bf16* KHAT = RHAT + 64 * RW_TS; LAS bf16* AHAT = KHAT + 64 * RW_TS; LAS bf16* VB = AHAT + 64 * RW_TS;
    LAS float* LW = (LAS float*)(VB + 64 * RW_TS);
    LAS float* YY = LW + 4096;
    LAS float* LA = YY + 4096;
    LAS bf16* LK = (LAS bf16*)(LA + 1024);
    LAS bf16* UINV = LK + 1024; LAS bf16* G3M = UINV + 1024; LAS bf16* G4M = G3M + 1024;
    LAS float* GT = (LAS float*)(G4M + 1024);
    LAS float* BD = GT + 256;
    LAS float* PRM = BD + 64;
    const bf16* Z = (const bf16*)(a->ws + WS_Z); const bf16* DEC = (const bf16*)(a->ws + WS_DEC); const bf16* AAp = (const bf16*)(a->ws + WS_AA); const bf16* GG = (const bf16*)(a->ws + WS_GG);
    bf16* CAT = (bf16*)(a->ws + WS_CAT);
    const float* mu = a->in[I_MU]; const float* k_k = a->in[I_KK]; const float* k_a = a->in[I_KA]; const float* r_k = a->in[I_RK]; const float* ln_w = a->in[I_LNW]; const float* ln_b = a->in[I_LNB];
    const int b = bh >> 5, h = bh & 31, lane = tid & 63, wave = __builtin_amdgcn_readfirstlane(tid >> 6);
    const int ltt = tid >> 3, lcc = tid & 7, c0 = h * 64 + lcc * 8;
    const int i = lane & 15, g = lane >> 4, q4 = i >> 2, p4 = i & 3;
    const s16x4_t z4 = (s16x4_t){0, 0, 0, 0};
    f32x4 X[4];
#pragma unroll
    for (int t = 0; t < 4; ++t) X[t] = (f32x4){0.f, 0.f, 0.f, 0.f};
    RwkvRaw R; rwkv_load(R, Z, DEC, AAp, GG, b, h, 0, ltt, lcc);
    { const int p = tid >> 6, cc = h * 64 + (tid & 63);
      PRM[tid] = (p < 3) ? mu[p * 2048 + cc] : (p == 3) ? k_k[cc] : (p == 4) ? k_a[cc] : (p == 5) ? r_k[cc] : (p == 6) ? ln_w[cc] : ln_b[cc]; }
    LDS_WAIT(); __syncthreads();
    for (int j = 0; j < SEQ / 64; ++j) {
        const v4u gk = R.g;
        float rs[8], kkr[8], kt[8], ka[8], vs[8], lwv[8];
        {
            float ks[8], av[8], mur[8], muk[8], muv[8], pkk[8], pka[8], prk[8];
#pragma unroll
            for (int x = 0; x < 8; x += 4) { const LAS float* pp = PRM + lcc * 8 + x;
                const f32x4 a0 = *(const LAS f32x4*)pp, a1 = *(const LAS f32x4*)(pp + 64), a2 = *(const LAS f32x4*)(pp + 128), a3 = *(const LAS f32x4*)(pp + 192), a4 = *(const LAS f32x4*)(pp + 256), a5 = *(const LAS f32x4*)(pp + 320);
#pragma unroll
                for (int y = 0; y < 4; ++y) { mur[x + y] = a0[y]; muk[x + y] = a1[y]; muv[x + y] = a2[y]; pkk[x + y] = a3[y]; pka[x + y] = a4[y]; prk[x + y] = a5[y]; } }
#pragma unroll
            for (int e = 0; e < 4; ++e) {
                float c, p;
                c = bflo(R.zr[e]); p = bflo(R.zrp[e]); rs[2 * e] = c + (p - c) * mur[2 * e];
                c = bfhi(R.zr[e]); p = bfhi(R.zrp[e]); rs[2 * e + 1] = c + (p - c) * mur[2 * e + 1];
                c = bflo(R.zk[e]); p = bflo(R.zkp[e]); ks[2 * e] = c + (p - c) * muk[2 * e];
                c = bfhi(R.zk[e]); p = bfhi(R.zkp[e]); ks[2 * e + 1] = c + (p - c) * muk[2 * e + 1];
                c = bflo(R.zv[e]); p = bflo(R.zvp[e]); vs[2 * e] = c + (p - c) * muv[2 * e];
                c = bfhi(R.zv[e]); p = bfhi(R.zvp[e]); vs[2 * e + 1] = c + (p - c) * muv[2 * e + 1];
            }
#pragma unroll
            for (int e = 0; e < 4; ++e) { av[2 * e] = bflo(R.a[e]); av[2 * e + 1] = bfhi(R.a[e]); lwv[2 * e] = bflo(R.d[e]); lwv[2 * e + 1] = bfhi(R.d[e]); }
            float q = 0.f;
#pragma unroll
            for (int e = 0; e < 8; ++e) { kkr[e] = ks[e] * pkk[e]; q += kkr[e] * kkr[e]; }
            q = red8(q);
            const float inv = 1.0f / fmaxf(sqrtf(q), 1e-12f);
            float bd = 0.f;
#pragma unroll
            for (int e = 0; e < 8; ++e) { kkr[e] *= inv; kt[e] = ks[e] * (1.f + (av[e] - 1.f) * pka[e]); ka[e] = kkr[e] * av[e]; bd += rs[e] * kt[e] * prk[e]; }
            bd = red8(bd);
            *(LAS f32x4*)(LW + ltt * 64 + lcc * 8) = (f32x4){lwv[0], lwv[1], lwv[2], lwv[3]}; *(LAS f32x4*)(LW + ltt * 64 + lcc * 8 + 4) = (f32x4){lwv[4], lwv[5], lwv[6], lwv[7]};
            if (lcc == 0) BD[ltt] = bd;
        }
        LDS_WAIT(); __syncthreads();
        if (j + 1 < SEQ / 64) rwkv_load(R, Z, DEC, AAp, GG, b, h, j + 1, ltt, lcc);
        if (tid < 256) { LAS float* p = LW + (tid >> 6) * 1024 + (tid & 63); float x[16], acc = 0.f;
#pragma unroll
            for (int s = 0; s < 16; ++s) x[s] = p[s * 64];
#pragma unroll
            for (int s = 0; s < 16; ++s) { p[s * 64] = acc; acc += x[s]; } }
        LDS_WAIT(); __syncthreads();
        {
            const int sc = ltt >> 4, tl = ltt & 15;
            const f32x4 l0 = *(const LAS f32x4*)(LW + ltt * 64 + lcc * 8), l1 = *(const LAS f32x4*)(LW + ltt * 64 + lcc * 8 + 4);
            const float lgm[8] = {l0[0], l0[1], l0[2], l0[3], l1[0], l1[1], l1[2], l1[3]};
            float o0[8], o1[8], o2[8], o3[8], egl[8];
#pragma unroll
            for (int e = 0; e < 8; ++e) { const float em = fexp2(lgm[e]), el = em * fexp2(lwv[e]), iv = frcp(el);
                o0[e] = kkr[e] * em; o1[e] = rs[e] * el; o2[e] = kt[e] * iv; o3[e] = ka[e] * iv; egl[e] = el; }
            const int o = ltt * RW_TS + lcc * 8;
            *(LAS v4u*)(KAP + o) = pack8(o0); *(LAS v4u*)(RHAT + o) = pack8(o1); *(LAS v4u*)(KHAT + o) = pack8(o2); *(LAS v4u*)(AHAT + o) = pack8(o3); *(LAS v4u*)(VB + o) = pack8(vs);
            if (tl == 15) { *(LAS f32x4*)(GT + sc * 64 + lcc * 8) = (f32x4){egl[0], egl[1], egl[2], egl[3]}; *(LAS f32x4*)(GT + sc * 64 + lcc * 8 + 4) = (f32x4){egl[4], egl[5], egl[6], egl[7]}; }
        }
        LDS_WAIT(); __syncthreads();
        if (wave < 4) {
            const int sc = wave; const LAS bf16* kap = KAP + 16 * sc * RW_TS + i * RW_TS + 8 * g; const LAS bf16* rha = RHAT + 16 * sc * RW_TS + i * RW_TS + 8 * g;
            const LAS bf16* kha = KHAT + 16 * sc * RW_TS + i * RW_TS + 8 * g; const LAS bf16* aha = AHAT + 16 * sc * RW_TS + i * RW_TS + 8 * g;
            f32x4 g1 = (f32x4){0.f, 0.f, 0.f, 0.f}, g2 = g1, g3 = g1, g4 = g1;
#pragma unroll
            for (int ks = 0; ks < 2; ++ks) { const s16x8_t fa = *(const LAS s16x8_t*)(kap + 32 * ks), fr = *(const LAS s16x8_t*)(rha + 32 * ks), fk = *(const LAS s16x8_t*)(kha + 32 * ks), fh = *(const LAS s16x8_t*)(aha + 32 * ks);
                g1 = MFMA16(fa, fh, g1); g2 = MFMA16(fa, fk, g2); g3 = MFMA16(fr, fk, g3); g4 = MFMA16(fr, fh, g4); }
            { f32x4 lt4;
#pragma unroll
              for (int r = 0; r < 4; ++r) { const int t = 4 * g + r, o = sc * 256 + t * 16 + i; const bool lo = i < t, le = i <= t;
                lt4[r] = lo ? g1[r] : 0.f; LK[o] = (bf16)f2bf(lo ? g2[r] : 0.f); G3M[o] = (bf16)f2bf(le ? g3[r] : 0.f); G4M[o] = (bf16)f2bf(le ? g4[r] : 0.f); }
              *(LAS f32x4*)(LA + sc * 256 + i * 16 + 4 * g) = lt4; }
            LDS_WAIT(); asm volatile("" ::: "memory");
            float x[16];
#pragma unroll
            for (int t = 0; t < 16; ++t) x[t] = (i == t) ? 1.f : 0.f;
#pragma unroll
            for (int s2 = 0; s2 < 15; ++s2) {
#pragma unroll
                for (int t4 = (s2 + 1) & ~3; t4 < 16; t4 += 4) { const f32x4 l4 = *(const LAS f32x4*)(LA + sc * 256 + s2 * 16 + t4);
#pragma unroll
                    for (int e = 0; e < 4; ++e) if (t4 + e > s2) x[t4 + e] -= l4[e] * x[s2]; } }
            if (g == 0) {
#pragma unroll
                for (int t = 0; t < 16; ++t) UINV[sc * 256 + t * 16 + i] = (bf16)f2bf(x[t]); }
        }
        LDS_WAIT(); __syncthreads();
        if (wave < 4) {
            const int jv = wave;
#pragma unroll 2
            for (int sc = 0; sc < 4; ++sc) {
                const int r0 = 16 * sc;
                v4u xw0, xw1;
                xw0.x = pk2(X[0][0], X[0][1]); xw0.y = pk2(X[0][2], X[0][3]); xw0.z = pk2(X[1][0], X[1][1]); xw0.w = pk2(X[1][2], X[1][3]);
                xw1.x = pk2(X[2][0], X[2][1]); xw1.y = pk2(X[2][2], X[2][3]); xw1.z = pk2(X[3][0], X[3][1]); xw1.w = pk2(X[3][2], X[3][3]);
                const s16x8_t xb0 = __builtin_bit_cast(s16x8_t, xw0), xb1 = __builtin_bit_cast(s16x8_t, xw1);
                const s16x8_t vf = cat4(lds_tr4(VB + (r0 + 4 * g + q4) * RW_TS + 16 * jv + 4 * p4), z4);
                const int so = sc * 256 + i * 16 + 4 * g;
                f32x4 accB = MFMA16(cat4(*(const LAS s16x4_t*)(LK + so), z4), vf, ((f32x4){0.f, 0.f, 0.f, 0.f}));
                f32x4 accY = MFMA16(cat4(*(const LAS s16x4_t*)(G3M + so), z4), vf, ((f32x4){0.f, 0.f, 0.f, 0.f}));
                { const LAS bf16* kp = KAP + (r0 + i) * RW_TS + 4 * g; const LAS bf16* rp = RHAT + (r0 + i) * RW_TS + 4 * g;
                  accB = MFMA16(cat4(*(const LAS s16x4_t*)kp, *(const LAS s16x4_t*)(kp + 16)), xb0, accB); accB = MFMA16(cat4(*(const LAS s16x4_t*)(kp + 32), *(const LAS s16x4_t*)(kp + 48)), xb1, accB);
                  accY = MFMA16(cat4(*(const LAS s16x4_t*)rp, *(const LAS s16x4_t*)(rp + 16)), xb0, accY); accY = MFMA16(cat4(*(const LAS s16x4_t*)(rp + 32), *(const LAS s16x4_t*)(rp + 48)), xb1, accY); }
#pragma unroll
                for (int kt4 = 0; kt4 < 4; ++kt4) X[kt4] = MFMA16(cat4(lds_tr4(KHAT + (r0 + 4 * g + q4) * RW_TS + 16 * kt4 + 4 * p4), z4), vf, X[kt4]);
                v4u bw; bw.x = pk2(accB[0], accB[1]); bw.y = pk2(accB[2], accB[3]); bw.z = 0u; bw.w = 0u;
                const f32x4 accU = MFMA16(cat4(*(const LAS s16x4_t*)(UINV + so), z4), __builtin_bit_cast(s16x8_t, bw), ((f32x4){0.f, 0.f, 0.f, 0.f}));
                v4u uw; uw.x = pk2(-accU[0], -accU[1]); uw.y = pk2(-accU[2], -accU[3]); uw.z = 0u; uw.w = 0u;
                const s16x8_t unf = __builtin_bit_cast(s16x8_t, uw);
                accY = MFMA16(cat4(*(const LAS s16x4_t*)(G4M + so), z4), unf, accY);
#pragma unroll
                for (int kt4 = 0; kt4 < 4; ++kt4) { X[kt4] = MFMA16(cat4(lds_tr4(AHAT + (r0 + 4 * g + q4) * RW_TS + 16 * kt4 + 4 * p4), z4), unf, X[kt4]);
                    X[kt4] = X[kt4] * *(const LAS f32x4*)(GT + sc * 64 + 16 * kt4 + 4 * g); }
#pragma unroll
                for (int r = 0; r < 4; ++r) YY[(r0 + 4 * g + r) * 64 + 16 * jv + i] = accY[r];
            }
        }
        LDS_WAIT(); __syncthreads();
        {
            const int o = ltt * 64 + lcc * 8; const size_t gt = (size_t)b * SEQ + j * 64 + ltt;
            const f32x4 ya = *(const LAS f32x4*)(YY + o), yb = *(const LAS f32x4*)(YY + o + 4); const v4u vw = *(const LAS v4u*)(VB + ltt * RW_TS + lcc * 8);
            float y[8] = {ya[0], ya[1], ya[2], ya[3], yb[0], yb[1], yb[2], yb[3]};
            float vq[8] = {bflo(vw[0]), bfhi(vw[0]), bflo(vw[1]), bfhi(vw[1]), bflo(vw[2]), bfhi(vw[2]), bflo(vw[3]), bfhi(vw[3])};
            float gq[8] = {bflo(gk[0]), bfhi(gk[0]), bflo(gk[1]), bfhi(gk[1]), bflo(gk[2]), bfhi(gk[2]), bflo(gk[3]), bfhi(gk[3])};
            float s = 0.f;
#pragma unroll
            for (int e = 0; e < 8; ++e) s += y[e];
            const float mean = red8(s) * (1.f / 64.f); float q = 0.f;
#pragma unroll
            for (int e = 0; e < 8; ++e) { y[e] -= mean; q += y[e] * y[e]; }
            const float rstd = 1.0f / sqrtf(red8(q) * (1.f / 64.f) + GN_EPS), bd = BD[ltt];
            const LAS float* lp = PRM + 384 + lcc * 8; const f32x4 w0 = *(const LAS f32x4*)lp, w1 = *(const LAS f32x4*)(lp + 4), b0 = *(const LAS f32x4*)(lp + 64), b1 = *(const LAS f32x4*)(lp + 68);
            const float lw8[8] = {w0[0], w0[1], w0[2], w0[3], w1[0], w1[1], w1[2], w1[3]}, lb8[8] = {b0[0], b0[1], b0[2], b0[3], b1[0], b1[1], b1[2], b1[3]};
            float ov[8];
#pragma unroll
            for (int e = 0; e < 8; ++e) ov[e] = (y[e] * rstd * lw8[e] + lb8[e] + bd * vq[e]) * gq[e];
            *(GAS v4u*)(CAT + gt * D + 2048 + c0) = pack8(ov);
        }
        LDS_WAIT(); __syncthreads();
    }
}

constexpr int ML_QS = 264, ML_VS = 136, ML_PS = 72;
constexpr int ML_KS = 272, ML_VGS = 144, ML_QP = 272;
__device__ __forceinline__ void ml_scalars(LAS float* SC, int lane, float& mprev) {
    const float li = SC[lane], lf = SC[64 + lane];
    const float b = scan_add64(lf);
    const float gq = li - b, mx = scan_max64(gq);
    const float mm = fmaxf(mx, mprev);
    SC[128 + lane] = -mm; SC[192 + lane] = gq; SC[256 + lane] = expf(mprev - mm); SC[384 + lane] = expf(-(b + mm));
    const float blast = lane63(b), mlast = lane63(mx);
    const float mnew = fmaxf(blast + mprev, blast + mlast);
    SC[320 + lane] = expf(blast + gq - mnew);
    if (lane == 0) SC[448] = expf(blast + mprev - mnew);
    mprev = mnew;
}
struct MlRaw { v4u q[4], k[4], v[2]; float gi, gf; };
template <bool WITH_V> __device__ __forceinline__ void ml_load(MlRaw& R, const bf16* Z, const float* ZG, int b, int h, int dvs, int c, int row, int seg) {
    const int tid_ = row * 8 + seg;
    const bf16* z0 = Z + ((size_t)b * SEQ + c * 64) * LDZ1;
#pragma unroll
    for (int e = 0; e < 4; ++e) { const bf16* zr = z0 + (size_t)((tid_ >> 5) + 16 * e) * LDZ1 + h * 256 + (tid_ & 31) * 8; R.q[e] = *(const GAS v4u*)(zr + MC_Q); R.k[e] = *(const GAS v4u*)(zr + MC_K); }
    if (WITH_V) {
#pragma unroll
        for (int e = 0; e < 2; ++e) R.v[e] = *(const GAS v4u*)(z0 + (size_t)((tid_ >> 4) + 32 * e) * LDZ1 + MC_V + h * 512 + dvs * 128 + (tid_ & 15) * 8); }
    { const float* zp = ZG + (size_t)seg * M * 16 + ((size_t)b * SEQ + c * 64 + row) * 16 + h;
      R.gi = *(const GAS float*)zp; R.gf = *(const GAS float*)(zp + 8); }
}
template <int QP, int KP, bool QPERM> __device__ __forceinline__ f32x4 ml_s_tile(const LAS bf16* Qs, const LAS bf16* Ks, int lt, int st, int i, int g) {
    f32x4 acc = (f32x4){0.f, 0.f, 0.f, 0.f};
    const LAS bf16* qa = Qs + (16 * lt + i) * QP + 8 * g; const LAS bf16* kb = Ks + (16 * st + i) * KP + (QPERM ? 4 * g : 8 * g);
#pragma unroll
    for (int ks = 0; ks < 8; ++ks) acc = MFMA16(*(const LAS s16x8_t*)(qa + 32 * ks), QPERM ? cat4(*(const LAS s16x4_t*)(kb + 32 * ks), *(const LAS s16x4_t*)(kb + 32 * ks + 16)) : *(const LAS s16x8_t*)(kb + 32 * ks), acc);
    return acc;
}
__device__ __forceinline__ void mlstm_num_phase(LAS unsigned char* lds, const CAS Args* a, int w, int tid) {
    LAS bf16* Qs = (LAS bf16*)lds;
    LAS bf16* Ks = Qs + 64 * ML_QP;
    LAS bf16* Vs = Ks + 64 * ML_KS;
    LAS bf16* VGs = Vs + 64 * ML_VS;
    LAS bf16* Ps = VGs + 64 * ML_VGS;
    LAS float* SC = (LAS float*)(Ps + 64 * ML_PS);
    static_assert((64 * ML_QP + 64 * ML_KS + 2 * 64 * ML_VS + 64 * ML_VGS + 64 * ML_PS) * 2 + 2048 <= LDSCTL_OFF, "mLSTM numerator LDS map");
    LAS bf16* Os = (LAS bf16*)(SC + 512);
    const bf16* Z = (const bf16*)(a->ws + WS_Z); const float* ZG = (const float*)(a->ws + WS_ZP); bf16* NUM = (bf16*)(a->ws + WS_HRAW);
    const int bh = w >> 2, dvs = w & 3, b = bh >> 3, h = bh & 7, lane = tid & 63, wave = __builtin_amdgcn_readfirstlane(tid >> 6);
    const int row = tid >> 3, seg = tid & 7;
    const int i = lane & 15, g = lane >> 4, q4 = i >> 2, p4 = i & 3, dv0 = 16 * wave;
    const float bi = a->in[I_BI][h], bfv = a->in[I_BF][h];
    f32x4 C[16];
#pragma unroll
    for (int t = 0; t < 16; ++t) C[t] = (f32x4){0.f, 0.f, 0.f, 0.f};
    float mprev = 0.f;
    MlRaw R; ml_load<true>(R, Z, ZG, b, h, dvs, 0, row, seg);
    for (int c = 0; c < SEQ / 64; ++c) {
        __syncthreads();
#pragma unroll
        for (int e = 0; e < 4; ++e) { const int ch = tid & 31; LAS bf16* qd = Qs + ((tid >> 5) + 16 * e) * ML_QP + 32 * (ch >> 2) + 16 * (ch & 1) + 4 * ((ch >> 1) & 1);
            *(LAS v2u*)qd = (v2u){R.q[e].x, R.q[e].y}; *(LAS v2u*)(qd + 8) = (v2u){R.q[e].z, R.q[e].w};
            *(LAS v4u*)(Ks + ((tid >> 5) + 16 * e) * ML_KS + (tid & 31) * 8) = R.k[e]; }
#pragma unroll
        for (int e = 0; e < 2; ++e) *(LAS v4u*)(Vs + ((tid >> 4) + 32 * e) * ML_VS + (tid & 15) * 8) = R.v[e];
        { const float gi = red8(R.gi), gf = red8(R.gf); if (seg == 0) { SC[row] = gi + bi; SC[64 + row] = flogsig(gf + bfv); } }
        const v4u vk0 = R.v[0], vk1 = R.v[1];
        if (c + 1 < SEQ / 64) ml_load<true>(R, Z, ZG, b, h, dvs, c + 1, row, seg);
        if (c > 0) { const LAS v4u* op = (const LAS v4u*)(Os + row * ML_VS + seg * 16); const v4u o0 = op[0], o1 = op[1];
            GAS v4u* gp = (GAS v4u*)(NUM + ((size_t)b * SEQ + (c - 1) * 64 + row) * D + h * 512 + dvs * 128 + seg * 16); gp[0] = o0; gp[1] = o1; }
        LDS_WAIT(); __syncthreads();
        if (wave == 0) ml_scalars(SC, lane, mprev);
        LDS_WAIT(); __syncthreads();
#pragma unroll
        for (int e = 0; e < 2; ++e) { const int vr = (tid >> 4) + 32 * e; const float gw = SC[320 + vr]; const v4u vv = e ? vk1 : vk0; v4u o;
#pragma unroll
            for (int x = 0; x < 4; ++x) o[x] = pk2(bflo(vv[x]) * gw, bfhi(vv[x]) * gw);
            *(LAS v4u*)(VGs + vr * ML_VGS + (tid & 15) * 8) = o; }
        { const int lt = wave >> 1;
#pragma unroll
          for (int hh = 0; hh < 2; ++hh) { const int st = 2 * (wave & 1) + hh;
              f32x4 pv = (f32x4){0.f, 0.f, 0.f, 0.f};
              if (st <= lt) { const f32x4 acc = ml_s_tile<ML_QP, ML_KS, true>(Qs, Ks, lt, st, i, g); const f32x4 rt = *(const LAS f32x4*)(SC + 128 + 16 * lt + 4 * g); const float ct = SC[192 + 16 * st + i];
#pragma unroll
                  for (int r = 0; r < 4; ++r) pv[r] = (16 * st + i <= 16 * lt + 4 * g + r) ? acc[r] * 0.0625f * fexp2(1.4426950408889634f * (rt[r] + ct)) : 0.f; }
#pragma unroll
              for (int r = 0; r < 4; ++r) Ps[(16 * lt + 4 * g + r) * ML_PS + 16 * st + i] = (bf16)f2bf(pv[r]); } }
        LDS_WAIT(); __syncthreads();
        f32x4 nA[4], nB[4];
#pragma unroll
        for (int lt = 0; lt < 4; ++lt) { nA[lt] = (f32x4){0.f, 0.f, 0.f, 0.f}; nB[lt] = (f32x4){0.f, 0.f, 0.f, 0.f}; }
#pragma unroll
        for (int ks = 0; ks < 2; ++ks) { const LAS bf16* vp = Vs + (32 * ks + 8 * g + q4) * ML_VS + dv0 + 4 * p4;
            const s16x8_t bv = cat4(lds_tr4(vp), lds_tr4(vp + 4 * ML_VS));
#pragma unroll
            for (int lt = 0; lt < 4; ++lt) nA[lt] = MFMA16(*(const LAS s16x8_t*)(Ps + (16 * lt + i) * ML_PS + 32 * ks + 8 * g), bv, nA[lt]); }
        { s16x8_t qa[3][4];
#define ML_LDQ(dst, KS) _Pragma("unroll") for (int lt = 0; lt < 4; ++lt) dst[lt] = *(const LAS s16x8_t*)(Qs + (16 * lt + i) * ML_QP + 32 * (KS) + 8 * g);
          ML_LDQ(qa[0], 0) ML_LDQ(qa[1], 1)
          __builtin_amdgcn_sched_barrier(0);
#pragma unroll
          for (int ks = 0; ks < 8; ++ks) {
              if (ks + 2 < 8) { ML_LDQ(qa[(ks + 2) % 3], ks + 2) }
              v4u cw; cw.x = pk2(C[2 * ks][0], C[2 * ks][1]); cw.y = pk2(C[2 * ks][2], C[2 * ks][3]); cw.z = pk2(C[2 * ks + 1][0], C[2 * ks + 1][1]); cw.w = pk2(C[2 * ks + 1][2], C[2 * ks + 1][3]);
              const s16x8_t bc = __builtin_bit_cast(s16x8_t, cw);
#pragma unroll
              for (int lt = 0; lt < 4; ++lt) nB[lt] = MFMA16(qa[ks % 3][lt], bc, nB[lt]);
              __builtin_amdgcn_sched_barrier(0);
          }
#undef ML_LDQ
        }
        { s16x8_t ka[3][4], bv[2];
#define ML_LDK(dst, BQ) _Pragma("unroll") for (int u = 0; u < 4; ++u) { const LAS bf16* kp = Ks + (32 * ((BQ) >> 2) + 4 * g + q4) * ML_KS + 4 * p4 + 16 * (4 * ((BQ) & 3) + u); dst[u] = cat4(lds_tr4(kp), lds_tr4(kp + 16 * ML_KS)); }
          f32x4 it4[4];
#pragma unroll
          for (int lt = 0; lt < 4; ++lt) it4[lt] = *(const LAS f32x4*)(SC + 256 + 16 * lt + 4 * g);
          const float cd = SC[448];
#pragma unroll
          for (int ks = 0; ks < 2; ++ks) { const LAS bf16* vp = VGs + (32 * ks + 4 * g + q4) * ML_VGS + dv0 + 4 * p4; bv[ks] = cat4(lds_tr4(vp), lds_tr4(vp + 16 * ML_VGS)); }
          ML_LDK(ka[0], 0) ML_LDK(ka[1], 1)
          __builtin_amdgcn_sched_barrier(0);
#pragma unroll
          for (int lt = 0; lt < 4; ++lt) {
#pragma unroll
              for (int r = 0; r < 4; ++r) Os[(16 * lt + 4 * g + r) * ML_VS + dv0 + i] = (bf16)f2bf(nA[lt][r] + it4[lt][r] * 0.0625f * nB[lt][r]); }
#pragma unroll
          for (int t = 0; t < 16; ++t) C[t] = C[t] * cd;
          __builtin_amdgcn_sched_barrier(0);
#pragma unroll
          for (int bq = 0; bq < 8; ++bq) {
              if (bq + 2 < 8) { ML_LDK(ka[(bq + 2) % 3], bq + 2) }
#pragma unroll
              for (int u = 0; u < 4; ++u) C[4 * (bq & 3) + u] = MFMA16(ka[bq % 3][u], bv[bq >> 2], C[4 * (bq & 3) + u]);
              __builtin_amdgcn_sched_barrier(0);
          }
#undef ML_LDK
        }
    }
    LDS_WAIT(); __syncthreads();
    { const LAS v4u* op = (const LAS v4u*)(Os + row * ML_VS + seg * 16); const v4u o0 = op[0], o1 = op[1];
      GAS v4u* gp = (GAS v4u*)(NUM + ((size_t)b * SEQ + (SEQ - 64) + row) * D + h * 512 + dvs * 128 + seg * 16); gp[0] = o0; gp[1] = o1; }
}
__device__ __forceinline__ void mlstm_den_phase(LAS unsigned char* lds, const CAS Args* a, int bh, int tid) {
    LAS bf16* Qs = (LAS bf16*)lds; LAS bf16* Ks = Qs + 64 * ML_QS;
    LAS float* SC = (LAS float*)(Ks + 64 * ML_QS);
    LAS float* NS = SC + 512;
    LAS float* NP = NS + 256;
    LAS float* ROWP = NP + 512;
    LAS float* QN = ROWP + 256;
    const bf16* Z = (const bf16*)(a->ws + WS_Z); const float* ZG = (const float*)(a->ws + WS_ZP); float* DENG = (float*)(a->ws + WS_HSSQ); float* EMTG = DENG + (size_t)M * 8;
    const int b = bh >> 3, h = bh & 7, lane = tid & 63, wave = __builtin_amdgcn_readfirstlane(tid >> 6);
    const int row = tid >> 3, seg = tid & 7, i = lane & 15, g = lane >> 4;
    const float bi = a->in[I_BI][h], bfv = a->in[I_BF][h];
    if (tid < 256) NS[tid] = 0.f;
    float mprev = 0.f;
    MlRaw R; ml_load<false>(R, Z, ZG, b, h, 0, 0, row, seg);
    for (int c = 0; c < SEQ / 64; ++c) {
        __syncthreads();
#pragma unroll
        for (int e = 0; e < 4; ++e) { *(LAS v4u*)(Qs + ((tid >> 5) + 16 * e) * ML_QS + (tid & 31) * 8) = R.q[e]; *(LAS v4u*)(Ks + ((tid >> 5) + 16 * e) * ML_QS + (tid & 31) * 8) = R.k[e]; }
        { const float gi = red8(R.gi), gf = red8(R.gf); if (seg == 0) { SC[row] = gi + bi; SC[64 + row] = flogsig(gf + bfv); } }
        if (c + 1 < SEQ / 64) ml_load<false>(R, Z, ZG, b, h, 0, c + 1, row, seg);
        LDS_WAIT(); __syncthreads();
        if (wave == 0) ml_scalars(SC, lane, mprev);
        LDS_WAIT(); __syncthreads();
        { const int lt = wave >> 1;
#pragma unroll
          for (int hh = 0; hh < 2; ++hh) { const int st = 2 * (wave & 1) + hh;
              f32x4 pv = (f32x4){0.f, 0.f, 0.f, 0.f};
              if (st <= lt) { const f32x4 acc = ml_s_tile<ML_QS, ML_QS, false>(Qs, Ks, lt, st, i, g); const f32x4 rt = *(const LAS f32x4*)(SC + 128 + 16 * lt + 4 * g); const float ct = SC[192 + 16 * st + i];
#pragma unroll
                  for (int r = 0; r < 4; ++r) pv[r] = (16 * st + i <= 16 * lt + 4 * g + r) ? bf2f((bf16)f2bf(acc[r] * 0.0625f * fexp2(1.4426950408889634f * (rt[r] + ct)))) : 0.f; }
#pragma unroll
              for (int r = 0; r < 4; ++r) { const float s = red16(pv[r]); if (i == 0) ROWP[st * 64 + 16 * lt + 4 * g + r] = s; } } }
        { float acc = 0.f; const LAS bf16* qp = Qs + row * ML_QS + seg * 32; const LAS float* np = NS + seg * 32;
#pragma unroll
          for (int e = 0; e < 4; ++e) { const v4u qw = *(const LAS v4u*)(qp + 8 * e);
#pragma unroll
              for (int x = 0; x < 4; ++x) acc += bflo(qw[x]) * np[8 * e + 2 * x] + bfhi(qw[x]) * np[8 * e + 2 * x + 1]; }
          acc = red8(acc); if (seg == 0) QN[row] = acc; }
        LDS_WAIT(); __syncthreads();
        if (tid < 64) { const size_t t = (size_t)b * SEQ + c * 64 + tid;
            const float den = ((ROWP[tid] + ROWP[64 + tid]) + (ROWP[128 + tid] + ROWP[192 + tid])) + SC[256 + tid] * 0.0625f * QN[tid];
            DENG[t * 8 + h] = den; EMTG[t * 8 + h] = SC[384 + tid]; }
        { const int d = tid & 255, hf = tid >> 8; float acc = 0.f;
#pragma unroll 8
          for (int s = 0; s < 32; ++s) acc += bf2f(Ks[(hf * 32 + s) * ML_QS + d]) * SC[320 + hf * 32 + s];
          NP[hf * 256 + d] = acc; }
        LDS_WAIT(); __syncthreads();
        if (tid < 256) NS[tid] = SC[448] * NS[tid] + (NP[tid] + NP[256 + tid]);
    }
}
__device__ __forceinline__ void mlstm_post(const CAS Args* a, int gwave, int lane) {
    const bf16* Z = (const bf16*)(a->ws + WS_Z); const bf16* NUM = (const bf16*)(a->ws + WS_HRAW); const float* DENG = (const float*)(a->ws + WS_HSSQ); const float* EMTG = DENG + (size_t)M * 8;
    bf16* CAT = (bf16*)(a->ws + WS_CAT); const float* nw = a->in[I_MLNORM];
    for (int t = gwave; t < M; t += GRID * NWAVES) {
        f32x4 h0[8], h1[8]; v4u zo[8]; float q[8];
#pragma unroll
        for (int hd = 0; hd < 8; ++hd) { const int col = hd * 512 + lane * 8; const v4u hw = *(const GAS v4u*)(NUM + (size_t)t * D + col); h0[hd] = (f32x4){bflo(hw[0]), bfhi(hw[0]), bflo(hw[1]), bfhi(hw[1])}; h1[hd] = (f32x4){bflo(hw[2]), bfhi(hw[2]), bflo(hw[3]), bfhi(hw[3])};
            zo[hd] = *(const GAS v4u*)(Z + (size_t)t * LDZ1 + MC_O + col); }
#pragma unroll
        for (int hd = 0; hd < 8; ++hd) { const float den = ((const GAS float*)DENG)[t * 8 + hd], emt = ((const GAS float*)EMTG)[t * 8 + hd], dinv = 1.0f / fmaxf(fabsf(den), emt);
            h0[hd] = h0[hd] * dinv; h1[hd] = h1[hd] * dinv;
            q[hd] = ((h0[hd][0] * h0[hd][0] + h0[hd][1] * h0[hd][1]) + (h0[hd][2] * h0[hd][2] + h0[hd][3] * h0[hd][3])) + ((h1[hd][0] * h1[hd][0] + h1[hd][1] * h1[hd][1]) + (h1[hd][2] * h1[hd][2] + h1[hd][3] * h1[hd][3])); }
#pragma unroll
        for (int o = 1; o < 64; o <<= 1)
#pragma unroll
            for (int hd = 0; hd < 8; ++hd) q[hd] += __shfl_xor(q[hd], o);
#pragma unroll
        for (int hd = 0; hd < 8; ++hd) { const int col = hd * 512 + lane * 8; const float rs = 1.0f / sqrtf(q[hd] * (1.f / 512.f) + NORM_EPS);
            const f32x4 n0 = *(const f32x4*)(nw + col), n1 = *(const f32x4*)(nw + col + 4); float o[8];
#pragma unroll
            for (int x = 0; x < 4; ++x) { o[x] = h0[hd][x] * rs * n0[x]; o[4 + x] = h1[hd][x] * rs * n1[x]; }
#pragma unroll
            for (int x = 0; x < 4; ++x) { o[2 * x] *= fsigmoid(bflo(zo[hd][x])); o[2 * x + 1] *= fsigmoid(bfhi(zo[hd][x])); }
            v4u w; w.x = pk2(o[0], o[1]); w.y = pk2(o[2], o[3]); w.z = pk2(o[4], o[5]); w.w = pk2(o[6], o[7]);
            *(GAS v4u*)(CAT + (size_t)t * D + col) = w; }
    }
}
struct LruRaw { v4u z[4][4]; v4u gz; };
__device__ __forceinline__ void lru_load(LruRaw& R, const bf16* Z, int b, int hh, int slab, int j, int tt, int c8) {
    const int tpos = j * 64 + tt; const bf16* zrow = Z + ((size_t)b * SEQ + tpos) * LDZ0 + hh * 256;
#pragma unroll
    for (int e = 0; e < 4; ++e)
#pragma unroll
        for (int d = 0; d < 4; ++d) R.z[e][d] = (tpos - d >= 0) ? *(const GAS v4u*)(zrow - (size_t)d * LDZ0 + (c8 + 8 * e) * 8) : (v4u){0u, 0u, 0u, 0u};
    R.gz = *(const GAS v4u*)(zrow + 2048 + slab * 64 + c8 * 8);
}
__device__ __forceinline__ void rglru_phase(LAS unsigned char* lds, const CAS Args* a, int w, int tid) {
    LAS bf16* UCB = (LAS bf16*)lds;
    LAS float* RI = (LAS float*)(UCB + 64 * 264);
    LAS float* UCO = RI + 8192;
    LAS float* G_ = UCO + 4096;
    LAS float* CW = G_ + 4096;
    LAS float* SEG = CW + 1280;
    LAS float* HC = SEG + 1024;
    const bf16* Z = (const bf16*)(a->ws + WS_Z); bf16* CAT = (bf16*)(a->ws + WS_CAT);
    const float* cw = a->in[I_CONVW]; const float* cb = a->in[I_CONVB];
    const float* ba = a->in[I_BA]; const float* bx = a->in[I_BX]; const float* lam = a->in[I_LAM];
    const int b = w >> 5, hh = (w >> 2) & 7, slab = w & 3, lane = tid & 63, wave = __builtin_amdgcn_readfirstlane(tid >> 6);
    const int stt = tid >> 3, sc8 = tid & 7;
    const int jch = tid & 63, sg = tid >> 6, c = hh * 256 + slab * 64 + jch;
    const int i = lane & 15, g = lane >> 4, mt = wave >> 2, ct = wave & 3;
    for (int u = tid; u < 1280; u += NTHR) CW[u] = (u < 1024) ? cw[(u >> 8) * 2048 + hh * 256 + (u & 255)] : cb[hh * 256 + (u - 1024)];
    if (tid < 128) HC[tid] = 0.f;
    const float sp = softplusf_(-lam[c]), bav = ba[c], bxv = bx[c];
    s16x8_t bw[8];
    { const bf16* wt = (const bf16*)(a->ws + (mt ? WS_WXT : WS_WAT)) + (size_t)(slab * 64 + ct * 16 + i) * 2048 + hh * 256 + 8 * g;
#pragma unroll
      for (int ks = 0; ks < 8; ++ks) bw[ks] = *(const GAS s16x8_t*)(wt + 32 * ks); }
    LruRaw R; lru_load(R, Z, b, hh, slab, 0, stt, sc8);
    LDS_WAIT(); __syncthreads();
    for (int j = 0; j < SEQ / 64; ++j) {
#pragma unroll
        for (int e = 0; e < 4; ++e) { const int ch = (sc8 + 8 * e) * 8; float acc[8];
#pragma unroll
            for (int x = 0; x < 8; x += 4) { const f32x4 bb = *(const LAS f32x4*)(CW + 1024 + ch + x); acc[x] = bb[0]; acc[x + 1] = bb[1]; acc[x + 2] = bb[2]; acc[x + 3] = bb[3]; }
#pragma unroll
            for (int d = 0; d < 4; ++d) { const f32x4 w0 = *(const LAS f32x4*)(CW + (3 - d) * 256 + ch), w1 = *(const LAS f32x4*)(CW + (3 - d) * 256 + ch + 4); const v4u zz = R.z[e][d];
                acc[0] += w0[0] * bflo(zz[0]); acc[1] += w0[1] * bfhi(zz[0]); acc[2] += w0[2] * bflo(zz[1]); acc[3] += w0[3] * bfhi(zz[1]);
                acc[4] += w1[0] * bflo(zz[2]); acc[5] += w1[1] * bfhi(zz[2]); acc[6] += w1[2] * bflo(zz[3]); acc[7] += w1[3] * bfhi(zz[3]); }
            v4u o; o.x = pk2(acc[0], acc[1]); o.y = pk2(acc[2], acc[3]); o.z = pk2(acc[4], acc[5]); o.w = pk2(acc[6], acc[7]);
            *(LAS v4u*)(UCB + stt * 264 + ch) = o;
            if ((sc8 + 8 * e) >> 3 == slab) { LAS float* uo = UCO + stt * 64 + (ch - slab * 64); *(LAS f32x4*)uo = (f32x4){acc[0], acc[1], acc[2], acc[3]}; *(LAS f32x4*)(uo + 4) = (f32x4){acc[4], acc[5], acc[6], acc[7]}; } }
        { LAS float* gp = G_ + stt * 64 + sc8 * 8; const v4u zz = R.gz;
          *(LAS f32x4*)gp = (f32x4){fgelu_tanh(bflo(zz[0])), fgelu_tanh(bfhi(zz[0])), fgelu_tanh(bflo(zz[1])), fgelu_tanh(bfhi(zz[1]))};
          *(LAS f32x4*)(gp + 4) = (f32x4){fgelu_tanh(bflo(zz[2])), fgelu_tanh(bfhi(zz[2])), fgelu_tanh(bflo(zz[3])), fgelu_tanh(bfhi(zz[3]))}; }
        LDS_WAIT(); __syncthreads();
        if (j + 1 < SEQ / 64) lru_load(R, Z, b, hh, slab, j + 1, stt, sc8);
        { f32x4 acc[4];
#pragma unroll
          for (int t4 = 0; t4 < 4; ++t4) acc[t4] = (f32x4){0.f, 0.f, 0.f, 0.f};
#pragma unroll
          for (int ks = 0; ks < 8; ++ks)
#pragma unroll
              for (int t4 = 0; t4 < 4; ++t4) acc[t4] = MFMA16(*(const LAS s16x8_t*)(UCB + (16 * t4 + i) * 264 + 32 * ks + 8 * g), bw[ks], acc[t4]);
#pragma unroll
          for (int t4 = 0; t4 < 4; ++t4)
#pragma unroll
              for (int r = 0; r < 4; ++r) RI[mt * 4096 + (16 * t4 + 4 * g + r) * 64 + ct * 16 + i] = acc[t4][r]; }
        LDS_WAIT(); __syncthreads();
        float av[8], bv[8]; float pp = 1.f, hl = 0.f;
#pragma unroll
        for (int t8 = 0; t8 < 8; ++t8) { const int tt = sg * 8 + t8;
            const float rg = fsigmoid(RI[tt * 64 + jch] + bav), ig = fsigmoid(RI[4096 + tt * 64 + jch] + bxv), la = -8.0f * rg * sp;
            av[t8] = fexp(la); bv[t8] = __builtin_amdgcn_sqrtf(fmaxf(__builtin_fmaf(-av[t8], av[t8], 1.f), 0.f)) * (ig * UCO[tt * 64 + jch]);
            pp *= av[t8]; hl = av[t8] * hl + bv[t8]; }
        SEG[(sg * 64 + jch) * 2] = pp; SEG[(sg * 64 + jch) * 2 + 1] = hl;
        LDS_WAIT(); __syncthreads();
        { float hc = HC[(j & 1) * 64 + jch];
          for (int s2 = 0; s2 < sg; ++s2) hc = SEG[(s2 * 64 + jch) * 2] * hc + SEG[(s2 * 64 + jch) * 2 + 1];
#pragma unroll
          for (int t8 = 0; t8 < 8; ++t8) { const int tt = sg * 8 + t8; hc = av[t8] * hc + bv[t8]; RI[tt * 64 + jch] = hc * G_[tt * 64 + jch]; }
          if (sg == 7) HC[((j + 1) & 1) * 64 + jch] = hc; }
        LDS_WAIT(); __syncthreads();
        { const int tt = tid >> 3, c8 = (tid & 7) * 8; const f32x4 p = *(const LAS f32x4*)(RI + tt * 64 + c8), q = *(const LAS f32x4*)(RI + tt * 64 + c8 + 4);
          v4u o; o.x = pk2(p[0], p[1]); o.y = pk2(p[2], p[3]); o.z = pk2(q[0], q[1]); o.w = pk2(q[2], q[3]);
          *(GAS v4u*)(CAT + ((size_t)b * SEQ + j * 64 + tt) * D + hh * 256 + slab * 64 + c8) = o; }
        LDS_WAIT(); __syncthreads();
    }
}
__device__ __forceinline__ void final_norm(const CAS Args* a, int vcu, int wave, int lane) {
    const float* gw_ = a->in[I_NFIN]; const bf16* XB = (const bf16*)(a->ws + WS_XB); const int gw = vcu * NWAVES + wave, NGW = GRID * NWAVES;
    for (int m = gw; m < M; m += NGW) {
        const GAS v4u* xr = (const GAS v4u*)(XB + (size_t)m * D) + lane; v4u v[8]; float s = 0.f;
#pragma unroll
        for (int j = 0; j < 8; ++j) { v[j] = xr[64 * j];
#pragma unroll
            for (int x = 0; x < 4; ++x) { const float lo = bflo(v[j][x]), hi = bfhi(v[j][x]); s += lo * lo + hi * hi; } }
        const float rstd = 1.0f / sqrtf(wave_sum(s) * (1.0f / D) + NORM_EPS);
        GAS f32x4* orow = (GAS f32x4*)(a->out + (size_t)m * D);
#pragma unroll
        for (int j = 0; j < 8; ++j) { const int c8 = (lane + 64 * j) * 8; const f32x4 g0 = *(const f32x4*)(gw_ + c8), g1 = *(const f32x4*)(gw_ + c8 + 4);
            orow[c8 / 4] = (f32x4){bflo(v[j][0]) * rstd * g0[0], bfhi(v[j][0]) * rstd * g0[1], bflo(v[j][1]) * rstd * g0[2], bfhi(v[j][1]) * rstd * g0[3]};
            orow[c8 / 4 + 1] = (f32x4){bflo(v[j][2]) * rstd * g1[0], bfhi(v[j][2]) * rstd * g1[1], bflo(v[j][3]) * rstd * g1[2], bfhi(v[j][3]) * rstd * g1[3]}; }
    }
}

__device__ __forceinline__ const CAS Args* fresh_args() { const CAS Args* p = (const CAS Args*)__builtin_amdgcn_kernarg_segment_ptr(); asm volatile("" : "+s"(p)); return p; }
__device__ __forceinline__ bool in_phase(int k) { const CAS Args* p = fresh_args(); return p->ph_lo <= k && k < p->ph_hi; }
__device__ __forceinline__ int fresh_tid() { int t = threadIdx.x; asm volatile("" : "+v"(t)); return t; }
__device__ __forceinline__ int vcu_of() { const int bx = blockIdx.x; return (bx % 8) * (GRID / 8) + bx / 8; }
__device__ __forceinline__ void seam(LAS unsigned char* lds, int k) {
    if (MK_N_LAUNCHES != 1) return;
    if (in_phase(k) && in_phase(k + 1)) { const CAS Args* a = fresh_args(); XcdBarrier bar; bar.bar = (unsigned*)(a->ws + WS_CTL) + CW_BAR; bar.x = xb_xcc_id(); bar.st = (volatile LAS unsigned*)(lds + MISC_OFF) + 8; xcd_barrier(bar); }
}
template <int L> __device__ __forceinline__ void layer_phases(LAS unsigned char* lds) {
    constexpr int p_in = 1 + 7 * L, p_out = 5 + 6 * L, p_up = 6 + 6 * L, p_down = 7 + 6 * L;
    if (in_phase(p_in)) {
        const CAS Args* a = fresh_args(); unsigned char* ws = a->ws; const int tid = fresh_tid(); constexpr int ldz = L ? LDZ1 : LDZ0;
        pg8::Gemm g{(const bf16*)(ws + WS_XB), (const bf16*)(ws + (L ? WS_WMLIN : WS_WHYIN)), D, D, D};
        LAS float* rstab = (LAS float*)(lds + RS_OFF);
        if (L == 1) {
          constexpr int nmain = 12288;
          pg8::StaticOrder S; S.init(M, nmain, GRID, blockIdx.x);
          build_rs(rstab, S, (const float*)(ws + WS_SSQ), 64, tid);
          pg8::EpiScale<0> E{(bf16*)(ws + WS_Z), ldz, rstab};
          pg8::gemm_phase<pg8::EpiScale<0>, pg8::StaticOrder, true, true>(lds, g, S, E);
          const CAS Args* a2 = fresh_args(); unsigned char* ws2 = a2->ws; const int tid2 = fresh_tid();
          constexpr int SK = 8, KC = D / SK, NREM = 16;
          pg8::Gemm g2{(const bf16*)(ws2 + WS_XB), (const bf16*)(ws2 + WS_WMLIN) + (size_t)nmain * D, D, D, KC};
          pg8::SplitOrder S2; S2.init(M / 256, 1, SK, KC, GRID, blockIdx.x);
          build_rs(rstab, S2, (const float*)(ws2 + WS_SSQ), 64, tid2);
          pg8::EpiPartial E2{(float*)(ws2 + WS_ZP), NREM, NREM, M, rstab};
          pg8::gemm_phase<pg8::EpiPartial, pg8::SplitOrder, true, true>(lds, g2, S2, E2);
        } else if (blockIdx.x < G1_WGS) {
          pg8::StaticOrder S; S.init(M, LDZ0, G1_WGS, blockIdx.x);
          build_rs(rstab, S, (const float*)(ws + WS_SSQ), 1, tid);
          pg8::EpiScale<0> E{(bf16*)(ws + WS_Z), ldz, rstab};
          pg8::gemm_phase<pg8::EpiScale<0>, pg8::StaticOrder, true, true>(lds, g, S, E);
        } else {
          const int t2 = fresh_tid(); const int wv = __builtin_amdgcn_readfirstlane(t2 >> 6);
          conv_range(lds, fresh_args(), CONV_A0, CONV_A, (blockIdx.x - G1_WGS) * NWAVES + wv, (GRID - G1_WGS) * NWAVES, wv, t2 & 63);
        }
    }
    seam(lds, p_in);
    if (L == 0) {
        if (in_phase(2)) rwkv_prepass(fresh_args(), vcu_of() * NTHR + fresh_tid());
        seam(lds, 2);
        if (in_phase(3)) {
            for (int q = 0; q < 3; ++q) {
                const CAS Args* a = fresh_args(); unsigned char* ws = a->ws;
                const int kq = (q == 2) ? 256 : 128;
                pg8::Gemm g{(const bf16*)(ws + (q == 0 ? WS_AW : (q == 1 ? WS_AAL : WS_AG))), (const bf16*)(ws + (q == 0 ? WS_W2T : (q == 1 ? WS_A2T : WS_G2T))), kq, kq, kq};
                pg8::StaticOrder S; S.init(M, 2048, GRID, blockIdx.x);
                pg8::EpiLora E{(bf16*)(ws + (q == 0 ? WS_DEC : (q == 1 ? WS_AA : WS_GG))), 2048, q == 0 ? a->in[I_W0] : a->in[I_A0], q};
                pg8::gemm_phase<pg8::EpiLora, pg8::StaticOrder, true, true>(lds, g, S, E);
            }
        }
        seam(lds, 3);
        if (in_phase(4)) { const int vcu = vcu_of(); if (vcu < 128) rwkv_phase(lds, fresh_args(), vcu, fresh_tid()); else rglru_phase(lds, fresh_args(), vcu - 128, fresh_tid());
            conv_queue(lds, fresh_args(), CONV_A, CONV_B, 0, fresh_tid()); }
        seam(lds, 4);
    } else {
        if (in_phase(9)) { const int vcu = vcu_of(); if (vcu < 128) mlstm_num_phase(lds, fresh_args(), vcu, fresh_tid()); else if (vcu < 160) mlstm_den_phase(lds, fresh_args(), vcu - 128, fresh_tid());
            conv_queue(lds, fresh_args(), CONV_B, CONV_TOTAL, 1, fresh_tid()); }
        seam(lds, 9);
        if (in_phase(10)) { const int tid = fresh_tid(); mlstm_post(fresh_args(), vcu_of() * NWAVES + __builtin_amdgcn_readfirstlane(tid >> 6), tid & 63); }
        seam(lds, 10);
    }
    if (in_phase(p_out)) {
        const CAS Args* a = fresh_args(); unsigned char* ws = a->ws;
        pg8::Gemm g{(const bf16*)(ws + WS_CAT), (const bf16*)(ws + (L ? WS_WMLOUT : WS_WHYOUT)), D, D, D};
        pg8::StaticOrder S; S.init(M, D, GRID, blockIdx.x);
        pg8::EpiResid<false> E{(const bf16*)(ws + WS_XB), (bf16*)(ws + WS_XB), (float*)nullptr, (float*)(ws + WS_SSQ), D};
        pg8::gemm_phase<pg8::EpiResid<false>, pg8::StaticOrder, true, true>(lds, g, S, E);
    }
    seam(lds, p_out);
    if (in_phase(p_up)) {
        const CAS Args* a = fresh_args(); unsigned char* ws = a->ws; const int tid = fresh_tid();
        pg8::Gemm g{(const bf16*)(ws + WS_XB), (const bf16*)(ws + WS_WUP + (size_t)L * FF * D * 2), D, D, D};
        pg8::StaticOrder S; S.init(M, FF, GRID, blockIdx.x);
        LAS float* rstab = (LAS float*)(lds + RS_OFF);
        build_rs(rstab, S, (const float*)(ws + WS_SSQ), 64, tid);
        pg8::EpiScale<1> E{(bf16*)(ws + WS_U), FF, rstab};
        pg8::gemm_phase<pg8::EpiScale<1>, pg8::StaticOrder, true, true>(lds, g, S, E);
    }
    seam(lds, p_up);
    if (in_phase(p_down)) {
        const CAS Args* a = fresh_args(); unsigned char* ws = a->ws;
        pg8::Gemm g{(const bf16*)(ws + WS_U), (const bf16*)(ws + WS_WDOWN + (size_t)L * FF * D * 2), FF, FF, FF};
        pg8::StaticOrder S; S.init(M, D, GRID, blockIdx.x);
        pg8::EpiResid<false> E{(const bf16*)(ws + WS_XB), (bf16*)(ws + WS_XB), (float*)nullptr, (float*)(ws + WS_SSQ), D};
        pg8::gemm_phase<pg8::EpiResid<false>, pg8::StaticOrder, true, true>(lds, g, S, E);
    }
    seam(lds, p_down);
}
__global__ void __launch_bounds__(NTHR, 2) fwd_kernel(Args args) {
    extern __shared__ __attribute__((aligned(16))) unsigned char lds_raw[];
    LAS unsigned char* lds = (LAS unsigned char*)lds_raw;
    { const int tid = threadIdx.x;
      for (int u = tid; u < (LDS_BYTES - LDSCTL_OFF) / 4; u += NTHR) ((LAS unsigned*)(lds + LDSCTL_OFF))[u] = 0u;
      __syncthreads();
      if (MK_N_LAUNCHES == 1) { const CAS Args* a = fresh_args(); (void)xcd_barrier_post((unsigned*)(a->ws + WS_CTL) + CW_BAR, (volatile LAS unsigned*)(lds + MISC_OFF) + 8); } }
    if (in_phase(0)) { const int tid = fresh_tid(); p0_prologue(lds, fresh_args(), vcu_of(), __builtin_amdgcn_readfirstlane(tid >> 6), tid & 63); }
    seam(lds, 0);
    layer_phases<0>(lds);
    layer_phases<1>(lds);
    if (in_phase(14)) { const int tid = fresh_tid(); final_norm(fresh_args(), vcu_of(), __builtin_amdgcn_readfirstlane(tid >> 6), tid & 63); }
}

extern "C" void kernel_launch(void* const* d_in, const int* in_sizes, int n_in, void* d_out, int out_size, void* d_ws, size_t ws_size, hipStream_t stream) {
    static int ready = 0;
    if (ready == 0) {
        if (n_in != 31 || out_size != M * D || ws_size < WS_END) { fprintf(stderr, "kernel_launch: unexpected shapes (n_in %d, out %d, ws %zu < %zu); nothing launched\n", n_in, out_size, ws_size, (size_t)WS_END); ready = -1; return; }
        if (hipFuncSetAttribute((const void*)fwd_kernel, hipFuncAttributeMaxDynamicSharedMemorySize, LDS_BYTES) != hipSuccess) { fprintf(stderr, "kernel_launch: hipFuncSetAttribute failed\n"); ready = -1; return; }
        int per_cu = 0;
        if (hipOccupancyMaxActiveBlocksPerMultiprocessor(&per_cu, (const void*)fwd_kernel, NTHR, LDS_BYTES) != hipSuccess || per_cu < 1)
            fprintf(stderr, "kernel_launch: note: occupancy query reports %d workgroups per CU\n", per_cu);
        (void)hipGetLastError();
        ready = 1;
    }
    if (ready < 0) return;
    if (hipMemsetAsync((char*)d_ws + WS_CTL, 0, CTL_ZERO_BYTES, stream) != hipSuccess) { fprintf(stderr, "kernel_launch: memset failed\n"); return; }
    Args a{};
    for (int i = 0; i < 31; ++i) a.in[i] = (const float*)d_in[i];
    a.out = (float*)d_out; a.ws = (unsigned char*)d_ws;
    if (MK_N_LAUNCHES == 1) { a.ph_lo = 0; a.ph_hi = N_PHASES; hipLaunchKernelGGL(fwd_kernel, dim3(GRID), dim3(NTHR), LDS_BYTES, stream, a); }
    else { for (int p = 0; p < N_PHASES; ++p) { a.ph_lo = p; a.ph_hi = p + 1; hipLaunchKernelGGL(fwd_kernel, dim3(GRID), dim3(NTHR), LDS_BYTES, stream, a); } }
    const hipError_t le = hipPeekAtLastError();
    if (le != hipSuccess) fprintf(stderr, "kernel_launch: launch failed: %s\n", hipGetErrorName(le));
}
```

```cpp
#include <hip/hip_runtime.h>
#include <cstdio>
#include <cstdint>

#ifndef MK_N_LAUNCHES
#define MK_N_LAUNCHES 1
#endif

namespace pg8 {
#define PG8_LAS __attribute__((address_space(3)))
typedef unsigned short bf16_t;
typedef short bf16x8 __attribute__((ext_vector_type(8)));
typedef float f32x4 __attribute__((ext_vector_type(4)));
typedef unsigned u32x4 __attribute__((ext_vector_type(4)));
typedef unsigned u32x2 __attribute__((ext_vector_type(2)));
constexpr int BM = 256, BK = 64, HALF = 128, HTB = HALF * BK * 2  , STAGE_BYTES = 8 * HTB, NXCD = 8, WGM = 8;

__host__ __device__ __forceinline__ int lds_byte(int r, int c) { const int st = (r >> 4) * 2 + (c >> 5), rr = r & 15, cc = c & 31, ob = rr * 64 + cc * 2; return st * 1024 + (ob ^ (((ob >> 9) & 1) << 5)); }
__host__ __device__ __forceinline__ void stage_rc(int b, int& R, int& C) { const int st = b / 1024, sb = b % 1024, swz = sb ^ (((sb >> 9) & 1) << 5); R = (st >> 1) * 16 + swz / 64; C = (st & 1) * 32 + (swz % 64) / 2; }
__host__ __device__ __forceinline__ int perm32(int rho) { const int n = rho >> 4, i = rho & 15; return 8 * (i >> 2) + 4 * n + (i & 3); }

struct Unit { int pm, pn, ka, kb, ui, ks; };
struct Gemm { const bf16_t* A; const bf16_t* Bt; int lda, ldb, K; };

struct StaticOrder {
    int nM, nN, nwg, G, c;
    __host__ __device__ void init(int M, int N, int G_, int c_) { nM = M / BM; nN = N / BM; nwg = nM * nN; G = G_; c = c_; }
    __host__ __device__ bool next(int i, Unit& u) const {
        const long L = (long)i * G + c; if (L >= nwg) return false;
        int wgid = (int)L; { const int q = nwg / NXCD, r = nwg % NXCD, xcd = wgid % NXCD, off = wgid / NXCD; wgid = (xcd < r ? xcd * (q + 1) : r * (q + 1) + (xcd - r) * q) + off; }
        const int nig = WGM * nN, gid = wgid / nig, fm = gid * WGM, gsz = (nM - fm) < WGM ? (nM - fm) : WGM;
        u.pm = fm + ((wgid % nig) % gsz); u.pn = (wgid % nig) / gsz; u.ka = 0; u.kb = 0; u.ui = i; u.ks = 0; return true;
    }
    __device__ __forceinline__ void a_ready(const Unit&) const {}
    __device__ __forceinline__ void done(const Unit&) const {}
};
struct HeadOrder {
    int nM, nH, nwg, G, c, K;
    __host__ __device__ void init(int M, int nH_, int K_, int G_, int c_) { nM = M / BM; nH = nH_; nwg = nM * nH; G = G_; c = c_; K = K_; }
    __host__ __device__ bool next(int i, Unit& u) const {
        const long L = (long)i * G + c; if (L >= nwg) return false;
        u.pm = (int)(L % nM); u.pn = (int)(L / nM); u.ka = u.pn * K; u.kb = 0; u.ui = i; u.ks = 0; return true;
    }
    __device__ __forceinline__ void a_ready(const Unit&) const {}
    __device__ __forceinline__ void done(const Unit&) const {}
};

struct SplitOrder {
    int nN, S, Kc, nwg, G, c;
    __host__ __device__ void init(int nM, int nN_, int S_, int Kc_, int G_, int c_) { nN = nN_; S = S_; Kc = Kc_; nwg = nM * nN_ * S_; G = G_; c = c_; }
    __host__ __device__ bool next(int i, Unit& u) const {
        const long L = (long)i * G + c; if (L >= nwg) return false;
        const int per = S * nN, rem = (int)(L % per); u.pm = (int)(L / per); u.pn = rem / S; u.ks = rem % S; u.ka = u.ks * Kc; u.kb = u.ka; u.ui = i; return true;
    }
    __device__ __forceinline__ void a_ready(const Unit&) const {}
    __device__ __forceinline__ void done(const Unit&) const {}
};
__device__ __forceinline__ unsigned cvt_pk_bf16(float lo, float hi) { unsigned r; asm volatile("v_cvt_pk_bf16_f32 %0, %1, %2" : "=v"(r) : "v"(lo), "v"(hi)); return r; }

template <int ACT> struct EpiScale {
    static constexpr bool PERM = true, AFTER_DRAIN = false;
    bf16_t* O; int ldc; const PG8_LAS float* rs;
    __device__ __forceinline__ void operator()(const f32x4 (&acc)[2][2][4][2], const Unit& u, int wr, int wc, int fr, int fq) const {
        const int row0 = u.pm * BM + wr * 64 + fr, col0 = u.pn * BM + wc * 32 + 8 * fq;
        const PG8_LAS float* rt = rs + u.ui * 256 + wr * 64 + fr;
#pragma unroll
        for (int ai = 0; ai < 2; ++ai)
#pragma unroll
            for (int m = 0; m < 4; ++m) { bf16_t* rowp = O + (size_t)(row0 + ai * HALF + m * 16) * ldc + col0; const float s = rt[ai * HALF + m * 16];
#pragma unroll
                for (int bj = 0; bj < 2; ++bj) { f32x4 v0 = acc[ai][bj][m][0] * s, v1 = acc[ai][bj][m][1] * s;
                    if (ACT == 1) {
#pragma unroll
                        for (int e = 0; e < 4; ++e) { const float a = fmaxf(v0[e], 0.f), b = fmaxf(v1[e], 0.f); v0[e] = a * a; v1[e] = b * b; } }
                    u32x4 w; w.x = cvt_pk_bf16(v0[0], v0[1]); w.y = cvt_pk_bf16(v0[2], v0[3]); w.z = cvt_pk_bf16(v1[0], v1[1]); w.w = cvt_pk_bf16(v1[2], v1[3]);
                    *(u32x4*)(rowp + bj * HALF) = w; } }
    }
};
template <bool FINAL> struct EpiResid {
    static constexpr bool PERM = true, AFTER_DRAIN = false;
    const bf16_t* xb; bf16_t* xbo; float* out; float* ssq; int ldc;
    __device__ __forceinline__ void operator()(const f32x4 (&acc)[2][2][4][2], const Unit& u, int wr, int wc, int fr, int fq) const {
        const int col0 = u.pn * BM + wc * 32 + 8 * fq;
        u32x4 xin[2][4][2];
#pragma unroll
        for (int ai = 0; ai < 2; ++ai)
#pragma unroll
            for (int m = 0; m < 4; ++m)
#pragma unroll
                for (int bj = 0; bj < 2; ++bj) xin[ai][m][bj] = *(const u32x4*)(xb + (size_t)(u.pm * BM + ai * HALF + wr * 64 + m * 16 + fr) * ldc + col0 + bj * HALF);
#pragma unroll
        for (int ai = 0; ai < 2; ++ai)
#pragma unroll
            for (int m = 0; m < 4; ++m) { const int row = u.pm * BM + ai * HALF + wr * 64 + m * 16 + fr; float q = 0.f;
#pragma unroll
                for (int bj = 0; bj < 2; ++bj) { const size_t o = (size_t)row * ldc + col0 + bj * HALF;
                    const u32x4 xi = xin[ai][m][bj];
                    f32x4 v0 = acc[ai][bj][m][0], v1 = acc[ai][bj][m][1];
                    v0[0] += __builtin_bit_cast(float, xi.x << 16); v0[1] += __builtin_bit_cast(float, xi.x & 0xffff0000u); v0[2] += __builtin_bit_cast(float, xi.y << 16); v0[3] += __builtin_bit_cast(float, xi.y & 0xffff0000u);
                    v1[0] += __builtin_bit_cast(float, xi.z << 16); v1[1] += __builtin_bit_cast(float, xi.z & 0xffff0000u); v1[2] += __builtin_bit_cast(float, xi.w << 16); v1[3] += __builtin_bit_cast(float, xi.w & 0xffff0000u);
                    if (FINAL) { *(f32x4*)(out + o) = v0; *(f32x4*)(out + o + 4) = v1; }
                    else { u32x4 w; w.x = cvt_pk_bf16(v0[0], v0[1]); w.y = cvt_pk_bf16(v0[2], v0[3]); w.z = cvt_pk_bf16(v1[0], v1[1]); w.w = cvt_pk_bf16(v1[2], v1[3]); *(u32x4*)(xbo + o) = w;
                        q += ((v0[0] * v0[0] + v0[1] * v0[1]) + (v0[2] * v0[2] + v0[3] * v0[3])) + ((v1[0] * v1[0] + v1[1] * v1[1]) + (v1[2] * v1[2] + v1[3] * v1[3])); } }
                if (!FINAL) { q += __shfl_xor(q, 16); q += __shfl_xor(q, 32);
                    if (fq == 0) ssq[(size_t)row * 64 + u.pn * 4 + wc] = q; } }
    }
};
struct EpiPartial {
    static constexpr bool PERM = false, AFTER_DRAIN = false;
    float* P; int ldp, ncols, mrows; const PG8_LAS float* rs;
    __device__ __forceinline__ void operator()(const f32x4 (&acc)[2][2][4][2], const Unit& u, int wr, int wc, int fr, int fq) const {
        const int col0 = u.pn * BM + wc * 32 + 4 * fq; const PG8_LAS float* rt = rs + u.ui * 256 + wr * 64 + fr;
#pragma unroll
        for (int ai = 0; ai < 2; ++ai)
#pragma unroll
            for (int m = 0; m < 4; ++m) { const int row = u.pm * BM + ai * HALF + wr * 64 + m * 16 + fr; const float sc = rt[ai * HALF + m * 16];
                float* rp = P + ((size_t)u.ks * mrows + row) * ldp;
#pragma unroll
                for (int bj = 0; bj < 2; ++bj)
#pragma unroll
                    for (int n = 0; n < 2; ++n) { const int c = col0 + bj * HALF + 16 * n; if (c < ncols) *(f32x4*)(rp + c) = acc[ai][bj][m][n] * sc; } }
    }
};
struct EpiLora {
    static constexpr bool PERM = true, AFTER_DRAIN = false;
    bf16_t* O; int ldc; const float* bias; int kind;
    __device__ __forceinline__ void operator()(const f32x4 (&acc)[2][2][4][2], const Unit& u, int wr, int wc, int fr, int fq) const {
        const int col0 = u.pn * BM + wc * 32 + 8 * fq;
        f32x4 bb[2][2];
#pragma unroll
        for (int bj = 0; bj < 2; ++bj) { bb[bj][0] = (f32x4){0.f, 0.f, 0.f, 0.f}; bb[bj][1] = bb[bj][0]; if (kind != 2) { bb[bj][0] = *(const f32x4*)(bias + col0 + bj * HALF); bb[bj][1] = *(const f32x4*)(bias + col0 + bj * HALF + 4); } }
#pragma unroll
        for (int bj = 0; bj < 2; ++bj) { const int c = col0 + bj * HALF; const f32x4 b0 = bb[bj][0], b1 = bb[bj][1];
#pragma unroll
            for (int ai = 0; ai < 2; ++ai)
#pragma unroll
                for (int m = 0; m < 4; ++m) { const int row = u.pm * BM + ai * HALF + wr * 64 + m * 16 + fr; f32x4 v0 = acc[ai][bj][m][0] + b0, v1 = acc[ai][bj][m][1] + b1;
                    if (kind == 0) {
#pragma unroll
                        for (int e = 0; e < 4; ++e) { float x = -v0[e]; float sp = fmaxf(x, 0.f) + 0.6931471805599453f * __builtin_amdgcn_logf(1.f + __builtin_amdgcn_exp2f(-1.4426950408889634f * fabsf(x))); v0[e] = -1.4426950408889634f * __builtin_amdgcn_exp2f(-1.4426950408889634f * (sp + 0.5f));
                            x = -v1[e]; sp = fmaxf(x, 0.f) + 0.6931471805599453f * __builtin_amdgcn_logf(1.f + __builtin_amdgcn_exp2f(-1.4426950408889634f * fabsf(x))); v1[e] = -1.4426950408889634f * __builtin_amdgcn_exp2f(-1.4426950408889634f * (sp + 0.5f)); } }
                    else if (kind == 1) {
#pragma unroll
                        for (int e = 0; e < 4; ++e) { v0[e] = __builtin_amdgcn_rcpf(1.f + __builtin_amdgcn_exp2f(-1.4426950408889634f * v0[e])); v1[e] = __builtin_amdgcn_rcpf(1.f + __builtin_amdgcn_exp2f(-1.4426950408889634f * v1[e])); } }
                    u32x4 w; w.x = cvt_pk_bf16(v0[0], v0[1]); w.y = cvt_pk_bf16(v0[2], v0[3]); w.z = cvt_pk_bf16(v1[0], v1[1]); w.w = cvt_pk_bf16(v1[2], v1[3]);
                    *(u32x4*)(O + (size_t)row * ldc + c) = w; } }
    }
};


template <class Epi, class Sched, bool ALIGN_EPI = false, bool SP2 = false>
__device__ __forceinline__ void gemm_phase(PG8_LAS unsigned char* lds, const Gemm g, const Sched& S, const Epi& E) {
    const int tid = threadIdx.x, wid = __builtin_amdgcn_readfirstlane(tid >> 6), lane = tid & 63, wr = wid >> 2, wc = wid & 3, fr = lane & 15, fq = lane >> 4;
    const int K = g.K, nt = K / BK, lda = g.lda, ldb = g.ldb;
    unsigned voffA[2], voffB[2];
#pragma unroll
    for (int i = 0; i < 2; ++i) { int R, C; stage_rc(tid * 16 + i * 8192, R, C); const int Rb = Epi::PERM ? ((R & ~31) + perm32(R & 31)) : R;
        voffA[i] = (unsigned)(R * lda + C) * 2u; voffB[i] = (unsigned)(Rb * ldb + C) * 2u; }
    const size_t kstep = (size_t)(BK * 2);
    const size_t hstepA = (size_t)HALF * lda * 2, hstepB = (size_t)HALF * ldb * 2;
    const size_t tstepA = 2 * hstepA, tstepB = 2 * hstepB;
    const unsigned ldsw = (unsigned)wid * 1024u;
    const int aoff = lds_byte(wr * 64 + fr, fq * 8), boff = lds_byte(wc * 32 + fr, fq * 8);
#define PG8_SA(b, h) (((b) * 2 + (h)) * HTB)
#define PG8_SB(b, h) ((4 + (b) * 2 + (h)) * HTB)
#define PG8_STAGE(bufoff, gbase, voff) do { _Pragma("unroll") for (int _i = 0; _i < 2; ++_i) \
        __builtin_amdgcn_global_load_lds((const unsigned*)((const char*)(gbase) + (voff)[_i]), (PG8_LAS unsigned*)(lds + (bufoff) + ldsw + _i * 8192), 16, 0, 0); } while (0)
#define PG8_LDA(dst, b, h) do { _Pragma("unroll") for (int m = 0; m < 4; ++m) _Pragma("unroll") for (int k = 0; k < 2; ++k) dst[m][k] = *(const PG8_LAS bf16x8*)(lds + PG8_SA(b, h) + aoff + m * 2048 + k * 1024); } while (0)
#define PG8_LDB(dst, b, h) do { _Pragma("unroll") for (int n = 0; n < 2; ++n) _Pragma("unroll") for (int k = 0; k < 2; ++k) dst[n][k] = *(const PG8_LAS bf16x8*)(lds + PG8_SB(b, h) + boff + n * 2048 + k * 1024); } while (0)
#define PG8_MMA(ai, bj, At, Bt) do { __builtin_amdgcn_s_setprio(1); _Pragma("unroll") for (int m = 0; m < 4; ++m) _Pragma("unroll") for (int n = 0; n < 2; ++n) _Pragma("unroll") for (int k = 0; k < 2; ++k) \
        acc[ai][bj][m][n] = __builtin_amdgcn_mfma_f32_16x16x32_bf16(Bt[n][k], At[m][k], acc[ai][bj][m][n], 0, 0, 0); __builtin_amdgcn_s_setprio(0); } while (0)
#define PG8_WAIT_V(n) asm volatile("s_waitcnt vmcnt(" #n ")" ::: "memory")
#define PG8_WAIT_L(n) asm volatile("s_waitcnt lgkmcnt(" #n ")" ::: "memory")
#define PG8_BAR __builtin_amdgcn_s_barrier()
#define PG8_SCHED __builtin_amdgcn_sched_barrier(0)
    Unit cur, nxt; int ui = 0;
    if (!S.next(0, cur)) return;
    f32x4 acc[2][2][4][2];
#pragma unroll
    for (int a = 0; a < 2; ++a)
#pragma unroll
        for (int b = 0; b < 2; ++b)
#pragma unroll
            for (int m = 0; m < 4; ++m)
#pragma unroll
                for (int n = 0; n < 2; ++n) acc[a][b][m][n] = (f32x4){0.f, 0.f, 0.f, 0.f};
    bf16x8 At[4][2], B0[2][2], B1[2][2];
    const char* cA = (const char*)g.A + (size_t)cur.pm * tstepA + (size_t)cur.ka * 2; const char* cB = (const char*)g.Bt + (size_t)cur.pn * tstepB + (size_t)cur.kb * 2;
    S.a_ready(cur);
    if constexpr (SP2) {
        PG8_STAGE(PG8_SB(0, 0), cB, voffB); PG8_STAGE(PG8_SB(0, 1), cB + hstepB, voffB); PG8_STAGE(PG8_SA(0, 0), cA, voffA); PG8_STAGE(PG8_SA(0, 1), cA + hstepA, voffA);
        if (wr == 1) PG8_BAR;
        PG8_WAIT_V(2); PG8_BAR;
        PG8_STAGE(PG8_SB(1, 0), cB + kstep, voffB); PG8_STAGE(PG8_SA(1, 0), cA + kstep, voffA); PG8_STAGE(PG8_SB(1, 1), cB + hstepB + kstep, voffB);
        PG8_WAIT_V(6); PG8_BAR;
    } else {
        PG8_STAGE(PG8_SB(0, 0), cB, voffB); PG8_STAGE(PG8_SA(0, 0), cA, voffA); PG8_STAGE(PG8_SB(0, 1), cB + hstepB, voffB); PG8_STAGE(PG8_SA(0, 1), cA + hstepA, voffA);
        if (wr == 1) PG8_BAR;
        PG8_WAIT_V(4); PG8_BAR;
        PG8_STAGE(PG8_SB(1, 0), cB + kstep, voffB); PG8_STAGE(PG8_SA(1, 0), cA + kstep, voffA); PG8_STAGE(PG8_SB(1, 1), cB + hstepB + kstep, voffB);
        PG8_WAIT_V(6); PG8_BAR;
    }
    for (;;) {
        const bool has_next = S.next(ui + 1, nxt);
        const char* nA = has_next ? (const char*)g.A + (size_t)nxt.pm * tstepA + (size_t)nxt.ka * 2 : cA; const char* nB = has_next ? (const char*)g.Bt + (size_t)nxt.pn * tstepB + (size_t)nxt.kb * 2 : cB;
        for (int t = 0; t < nt; t += 2) {
            const bool last = (t == nt - 2);
            const char* a1 = cA + (size_t)(t + 1) * kstep;
            const char* a2 = last ? nA : cA + (size_t)(t + 2) * kstep; const char* b2 = last ? nB : cB + (size_t)(t + 2) * kstep;
            const char* a3 = a2 + kstep; const char* b3 = b2 + kstep;
            if (last && has_next) S.a_ready(nxt);
            if constexpr (SP2) {
            PG8_LDB(B0, 0, 0); PG8_LDB(B1, 0, 1); PG8_SCHED; PG8_LDA(At, 0, 0); PG8_STAGE(PG8_SA(1, 1), a1 + hstepA, voffA);
            PG8_WAIT_V(8); PG8_WAIT_L(0); PG8_BAR; PG8_MMA(0, 0, At, B0); PG8_MMA(0, 1, At, B1); PG8_BAR; PG8_SCHED;
            PG8_LDA(At, 0, 1); PG8_STAGE(PG8_SB(0, 0), b2, voffB); PG8_STAGE(PG8_SB(0, 1), b2 + hstepB, voffB); PG8_STAGE(PG8_SA(0, 0), a2, voffA);
            PG8_WAIT_V(8); PG8_WAIT_L(0); PG8_BAR; PG8_MMA(1, 0, At, B0); PG8_MMA(1, 1, At, B1); PG8_BAR; PG8_SCHED;
            PG8_LDB(B0, 1, 0); PG8_LDB(B1, 1, 1); PG8_SCHED; PG8_LDA(At, 1, 0); PG8_STAGE(PG8_SA(0, 1), a2 + hstepA, voffA);
            PG8_WAIT_V(8); PG8_WAIT_L(0); PG8_BAR; PG8_MMA(0, 0, At, B0); PG8_MMA(0, 1, At, B1); PG8_BAR; PG8_SCHED;
            PG8_LDA(At, 1, 1); PG8_STAGE(PG8_SB(1, 0), b3, voffB); PG8_STAGE(PG8_SB(1, 1), b3 + hstepB, voffB); PG8_STAGE(PG8_SA(1, 0), a3, voffA);
            PG8_WAIT_V(8); PG8_WAIT_L(0); PG8_BAR; PG8_MMA(1, 0, At, B0); PG8_MMA(1, 1, At, B1); PG8_BAR; PG8_SCHED;
            } else {
            PG8_LDB(B0, 0, 0); PG8_SCHED; PG8_LDA(At, 0, 0); PG8_STAGE(PG8_SA(1, 1), a1 + hstepA, voffA);
            PG8_WAIT_L(8); PG8_BAR; PG8_WAIT_L(0); PG8_MMA(0, 0, At, B0); PG8_BAR; PG8_SCHED;
            PG8_LDB(B1, 0, 1); PG8_STAGE(PG8_SB(0, 0), b2, voffB);
            PG8_BAR; PG8_WAIT_L(0); PG8_MMA(0, 1, At, B1); PG8_BAR;
            PG8_LDA(At, 0, 1); PG8_STAGE(PG8_SA(0, 0), a2, voffA);
            PG8_BAR; PG8_WAIT_L(0); PG8_MMA(1, 0, At, B0); PG8_BAR; PG8_SCHED;
            PG8_STAGE(PG8_SB(0, 1), b2 + hstepB, voffB);
            PG8_WAIT_V(6); PG8_BAR; PG8_MMA(1, 1, At, B1); PG8_BAR;
            PG8_LDB(B0, 1, 0); PG8_SCHED; PG8_LDA(At, 1, 0); PG8_STAGE(PG8_SA(0, 1), a2 + hstepA, voffA);
            PG8_WAIT_L(8); PG8_BAR; PG8_WAIT_L(0); PG8_MMA(0, 0, At, B0); PG8_BAR; PG8_SCHED;
            PG8_LDB(B1, 1, 1); PG8_STAGE(PG8_SB(1, 0), b3, voffB);
            PG8_BAR; PG8_WAIT_L(0); PG8_MMA(0, 1, At, B1); PG8_BAR;
            PG8_LDA(At, 1, 1); PG8_STAGE(PG8_SA(1, 0), a3, voffA);
            PG8_BAR; PG8_WAIT_L(0); PG8_MMA(1, 0, At, B0); PG8_BAR; PG8_SCHED;
            PG8_STAGE(PG8_SB(1, 1), b3 + hstepB, voffB);
            PG8_WAIT_V(6); PG8_BAR; PG8_MMA(1, 1, At, B1); PG8_BAR;
            }
        }
        if constexpr (ALIGN_EPI) { if (wr == 0) PG8_BAR; }
        if constexpr (!Epi::AFTER_DRAIN) { E(acc, cur, wr, wc, fr, fq); S.done(cur); }
        if (!has_next) break;
#pragma unroll
        for (int a = 0; a < 2; ++a)
#pragma unroll
            for (int b = 0; b < 2; ++b)
#pragma unroll
                for (int m = 0; m < 4; ++m)
#pragma unroll
                    for (int n = 0; n < 2; ++n) acc[a][b][m][n] = (f32x4){0.f, 0.f, 0.f, 0.f};
        cur = nxt; cA = nA; cB = nB; ++ui;
        if constexpr (ALIGN_EPI) { if (wr == 1) PG8_BAR; }
    }
    PG8_WAIT_V(0);
    if constexpr (!ALIGN_EPI) { if (wr == 0) PG8_BAR; }
    PG8_BAR;
    if constexpr (Epi::AFTER_DRAIN) { E.fused(acc, cur, wr, wc, fr, fq, lds, wid, lane); S.done(cur); }
#undef PG8_SA
#undef PG8_SB
#undef PG8_STAGE
#undef PG8_LDA
#undef PG8_LDB
#undef PG8_MMA
#undef PG8_WAIT_V
#undef PG8_WAIT_L
#undef PG8_BAR
#undef PG8_SCHED
}
}

constexpr int NWAVES = 8, NTHR = 512, GRID = 256;
constexpr int D = 4096, SEQ = 2048, NB = 4, M = NB * SEQ, FF = 4 * D;
constexpr int HY_IN = 10688, LDZ0 = 10752;
constexpr int ML_IN = 12304, LDZ1 = 12544;
constexpr int ZC_R = 4096, ZC_K = 6144, ZC_V = 8192, ZC_WL = 10240, ZC_AL = 10336, ZC_GL = 10432;
constexpr int MC_Q = 0, MC_K = 2048, MC_V = 4096, MC_O = 8192, MC_I = 12288, MC_F = 12296;
constexpr float NORM_EPS = 1e-6f, GN_EPS = 64e-5f;
constexpr int N_PHASES = 15;

constexpr size_t MiB = 1u << 20;
constexpr size_t WS_CTL = 0, CTL_ZERO_BYTES = 1 * MiB;
constexpr size_t WS_WHYIN = 1 * MiB;
constexpr size_t WS_WHYOUT = WS_WHYIN + (size_t)LDZ0 * D * 2;
constexpr size_t WS_WUP = WS_WHYOUT + (size_t)D * D * 2;
constexpr size_t WS_WDOWN = WS_WUP + 2 * (size_t)FF * D * 2;
constexpr size_t WS_WMLIN = WS_WDOWN + 2 * (size_t)FF * D * 2;
constexpr size_t WS_WMLOUT = WS_WMLIN + (size_t)LDZ1 * D * 2;
constexpr size_t WS_W2T = WS_WMLOUT + (size_t)D * D * 2;
constexpr size_t WS_A2T = WS_W2T + 2048 * 128 * 2;
constexpr size_t WS_G2T = WS_A2T + 2048 * 128 * 2;
constexpr size_t WS_WAT = WS_G2T + 2048 * 256 * 2;
constexpr size_t WS_WXT = WS_WAT + 256 * 2048 * 2;
constexpr size_t WS_XB = WS_WXT + 256 * 2048 * 2;
constexpr size_t WS_XF = WS_XB + (size_t)M * D * 2;
constexpr size_t WS_CAT = WS_XF + (size_t)M * D * 4;
constexpr size_t WS_SSQ = WS_CAT + (size_t)M * D * 2;
constexpr size_t WS_U = WS_SSQ + (size_t)M * 64 * 4;
constexpr size_t WS_Z = WS_U;
constexpr size_t WS_DEC = WS_U + (size_t)M * FF * 2;
constexpr size_t WS_AA = WS_DEC + (size_t)M * 2048 * 4;
constexpr size_t WS_GG = WS_AA + (size_t)M * 2048 * 4;
constexpr size_t WS_AW = WS_GG + (size_t)M * 2048 * 4;
constexpr size_t WS_AAL = WS_AW + (size_t)M * 128 * 2;
constexpr size_t WS_AG = WS_AAL + (size_t)M * 128 * 2;
constexpr size_t WS_HRAW = WS_DEC;
constexpr size_t WS_HSSQ = WS_GG;
constexpr size_t WS_ZP = WS_AG + (size_t)M * 256 * 2;
constexpr size_t WS_END = WS_ZP + 8 * (size_t)M * 16 * 4;
static_assert((size_t)M * LDZ1 * 2 <= (size_t)M * FF * 2, "Z fits in U's region");
static_assert(WS_HRAW + (size_t)M * D * 4 <= WS_GG, "HRAW fits in DEC|AA");
constexpr int CW_BAR = 4096;

constexpr int RING_BYTES = 131072;
constexpr int RS_OFF = RING_BYTES, RS_BYTES = 8192;
constexpr int LDSCTL_OFF = RS_OFF + RS_BYTES, MISC_OFF = LDSCTL_OFF + 320;
constexpr int LDS_BYTES = 147456;
static_assert(MISC_OFF + 128 <= LDS_BYTES, "LDS map");

#define GAS __attribute__((address_space(1)))
#define LAS __attribute__((address_space(3)))
typedef unsigned short bf16;
typedef unsigned v4u __attribute__((ext_vector_type(4)));
typedef unsigned v2u __attribute__((ext_vector_type(2)));
typedef float f32x4 __attribute__((ext_vector_type(4)));
typedef float f32x2 __attribute__((ext_vector_type(2)));
typedef GAS unsigned gu32;
#define RLX_AGENT __ATOMIC_RELAXED, __HIP_MEMORY_SCOPE_AGENT
#define LDS_WAIT() asm volatile("s_waitcnt lgkmcnt(0)" ::: "memory")
#define VM_WAIT() asm volatile("s_waitcnt vmcnt(0)" ::: "memory")
typedef __bf16 hwbf2_t __attribute__((ext_vector_type(2)));
__device__ __forceinline__ unsigned pk2(float lo, float hi) { const f32x2 v = {lo, hi}; return __builtin_bit_cast(unsigned, __builtin_convertvector(v, hwbf2_t)); }
__device__ __forceinline__ unsigned f2bf(float f) { return (unsigned)__builtin_bit_cast(unsigned short, (__bf16)f); }
__device__ __forceinline__ float bflo(unsigned w) { return __builtin_bit_cast(float, w << 16); }
__device__ __forceinline__ float bfhi(unsigned w) { return __builtin_bit_cast(float, w & 0xffff0000u); }
__device__ __forceinline__ float bf2f(bf16 h) { return __builtin_bit_cast(float, (unsigned)h << 16); }
__device__ __forceinline__ float sigmoidf_(float x) { return 1.f / (1.f + expf(-x)); }
__device__ __forceinline__ float fexp2(float x) { return __builtin_amdgcn_exp2f(x); }
__device__ __forceinline__ float fexp(float x) { return __builtin_amdgcn_exp2f(x * 1.4426950408889634f); }
__device__ __forceinline__ float frcp(float x) { return __builtin_amdgcn_rcpf(x); }
__device__ __forceinline__ float fsigmoid(float x) { return __builtin_amdgcn_rcpf(1.f + __builtin_amdgcn_exp2f(-1.4426950408889634f * x)); }
__device__ __forceinline__ float ftanh(float x) { return 1.f - 2.f * __builtin_amdgcn_rcpf(1.f + __builtin_amdgcn_exp2f(2.8853900817779268f * x)); }
__device__ __forceinline__ float flogsig(float x) {
    const float e = fexp2(-1.4426950408889634f * fabsf(x)), u = 1.f + e, d = u - 1.f;
    const float l = (d == 0.f) ? e : 0.6931471805599453f * __builtin_amdgcn_logf(u) * (e * frcp(d));
    return fminf(x, 0.f) - l;
}
template <int CTRL, int RM> __device__ __forceinline__ float dpp_id(float idv, float v) { return __builtin_bit_cast(float, __builtin_amdgcn_update_dpp(__builtin_bit_cast(int, idv), __builtin_bit_cast(int, v), CTRL, RM, 0xF, false)); }
__device__ __forceinline__ float scan_add64(float v) {
    v += dpp_id<0x111, 0xF>(0.f, v); v += dpp_id<0x112, 0xF>(0.f, v); v += dpp_id<0x114, 0xF>(0.f, v); v += dpp_id<0x118, 0xF>(0.f, v);
    v += dpp_id<0x142, 0xA>(0.f, v); v += dpp_id<0x143, 0xC>(0.f, v); return v; }
__device__ __forceinline__ float scan_max64(float v) { const float ni = -3.0e38f;
    v = fmaxf(v, dpp_id<0x111, 0xF>(ni, v)); v = fmaxf(v, dpp_id<0x112, 0xF>(ni, v)); v = fmaxf(v, dpp_id<0x114, 0xF>(ni, v)); v = fmaxf(v, dpp_id<0x118, 0xF>(ni, v));
    v = fmaxf(v, dpp_id<0x142, 0xA>(ni, v)); v = fmaxf(v, dpp_id<0x143, 0xC>(ni, v)); return v; }
__device__ __forceinline__ float lane63(float v) { return __builtin_bit_cast(float, __builtin_amdgcn_readlane(__builtin_bit_cast(int, v), 63)); }
__device__ __forceinline__ float fgelu_tanh(float x) { return 0.5f * x * (1.f + ftanh(0.7978845608028654f * (x + 0.044715f * x * x * x))); }
__device__ __forceinline__ float softplusf_(float x) { return fmaxf(x, 0.f) + log1pf(expf(-fabsf(x))); }
__device__ __forceinline__ float gelu_tanh(float x) { return 0.5f * x * (1.f + tanhf(0.7978845608028654f * (x + 0.044715f * x * x * x))); }
template <int CTRL> __device__ __forceinline__ float dpp_f(float v) { return __builtin_bit_cast(float, __builtin_amdgcn_update_dpp(0, __builtin_bit_cast(int, v), CTRL, 0xF, 0xF, false)); }
__device__ __forceinline__ float red4(float v) { v += dpp_f<0xB1>(v); v += dpp_f<0x4E>(v); return v; }
__device__ __forceinline__ float red8(float v) { v = red4(v); v += dpp_f<0x141>(v); return v; }
__device__ __forceinline__ float red16(float v) { v = red8(v); v += dpp_f<0x140>(v); return v; }


#define XB_TMO      128
#define XB_XCNT(j)  (256  + 64 * (j))
#define XB_XSUB(j)  (1280 + 64 * (j))
#define XB_XGEN(j)  (2304 + 64 * (j))
#define XB_TOP      3328
#define XB_TOPGEN   3392
#define XCD_BAR_WORDS 3456
#define XB_SPIN_CAP (1u << 18)

__device__ __forceinline__ unsigned xb_ld(unsigned* p)              { return __hip_atomic_load(p, __ATOMIC_RELAXED, __HIP_MEMORY_SCOPE_AGENT); }
__device__ __forceinline__ unsigned xb_add(unsigned* p, unsigned v) { return __hip_atomic_fetch_add(p, v, __ATOMIC_RELAXED, __HIP_MEMORY_SCOPE_AGENT); }
__device__ __forceinline__ unsigned xb_xcc_id() { return (unsigned)__builtin_amdgcn_s_getreg((3 << 11) | 20) & 0xFu; }
#define XB_SPIN(cond, bar) do { unsigned _sp = 0; while (cond) { __builtin_amdgcn_s_sleep(1); \
    if ((++_sp & 255u) == 0u) { if (xb_ld(&(bar)[XB_TMO])) break; if (_sp > XB_SPIN_CAP) { atomicAdd(&(bar)[XB_TMO], 1u); break; } } } } while (0)

struct XcdBarrier {
    unsigned* bar; unsigned x;
    volatile LAS unsigned* st;
};

__device__ __forceinline__ XcdBarrier xcd_barrier_post(unsigned* bar, volatile LAS unsigned* st) {
    XcdBarrier b; b.bar = bar; b.x = xb_xcc_id(); b.st = st;
    if (threadIdx.x == 0) (void)xb_add(&bar[XB_XCNT(b.x)], 1u);
    return b;
}
__device__ __forceinline__ void xcd_barrier_complete(unsigned* bar, unsigned x, unsigned& nloc, unsigned& nx) {
    const unsigned G = gridDim.x * gridDim.y * gridDim.z;
    unsigned sum, cnt, mine, sp = 0u;
    for (;;) {
        sum = 0u; cnt = 0u; mine = 0u;
#pragma unroll
        for (unsigned j = 0; j < 16; ++j) { const unsigned c = xb_ld(&bar[XB_XCNT(j)]); sum += c; cnt += (c > 0u) ? 1u : 0u; mine = (j == x) ? c : mine; }
        if (sum == G) break;
        __builtin_amdgcn_s_sleep(1);
        if ((++sp & 255u) == 0u) { if (xb_ld(&bar[XB_TMO])) break; if (sp > XB_SPIN_CAP) { atomicAdd(&bar[XB_TMO], 1u); break; } }
    }
    nloc = mine > 0u ? mine : 1u; nx = cnt > 0u ? cnt : 1u;
}

__device__ __forceinline__ void xcd_barrier(const XcdBarrier& b) {
    asm volatile("s_waitcnt vmcnt(0)" ::: "memory");
    __syncthreads();
    if (threadIdx.x == 0) {
        unsigned* bar = b.bar;
        __builtin_amdgcn_s_waitcnt(0);
        unsigned nloc = b.st[0], nx = b.st[1];
        if (nloc == 0u) { xcd_barrier_complete(bar, b.x, nloc, nx); b.st[0] = nloc; b.st[1] = nx; }
        const unsigned old = xb_add(&bar[XB_XSUB(b.x)], 1u);
        const unsigned gen = old / nloc;
        if (old + 1u == (gen + 1u) * nloc) {
            __builtin_amdgcn_fence(__ATOMIC_RELEASE, "agent");
            asm volatile("s_waitcnt vmcnt(0)" ::: "memory");
            const unsigned og = xb_add(&bar[XB_TOP], 1u);
            const unsigned tg = og / nx;
            if (og + 1u == (tg + 1u) * nx) xb_add(&bar[XB_TOPGEN], 1u);
            else XB_SPIN(xb_ld(&bar[XB_TOPGEN]) == tg, bar);
            __builtin_amdgcn_fence(__ATOMIC_ACQUIRE, "agent");
            xb_add(&bar[XB_XGEN(b.x)], 1u);
            asm volatile("s_waitcnt vmcnt(0)" ::: "memory");
        } else {
            XB_SPIN(xb_ld(&bar[XB_XGEN(b.x)]) == gen, bar);
            __builtin_amdgcn_fence(__ATOMIC_ACQUIRE, "agent");
            asm volatile("s_waitcnt vmcnt(0)" ::: "memory");
        }
    }
    __syncthreads();
}


struct Args { const float* in[31]; float* out; unsigned char* ws; int ph_lo, ph_hi; };
#define CAS __attribute__((address_space(4)))
enum { I_X = 0, I_NMIX, I_NMLP, I_NFIN, I_UP, I_DOWN, I_HYIN, I_CONVW, I_CONVB, I_WA, I_BA, I_WX, I_BX, I_LAM, I_MU, I_W0, I_W2, I_A0, I_A2, I_G2, I_KK, I_KA, I_RK,
       I_LNW, I_LNB, I_HYOUT, I_MLIN, I_BI, I_BF, I_MLNORM, I_MLOUT };

__device__ __forceinline__ float wave_sum(float v) {
#pragma unroll
    for (int o = 1; o < 64; o <<= 1) v += __shfl_xor(v, o);
    return v;
}

__device__ __forceinline__ void conv_item(const float* W, int K, int N, bf16* WT, int ldk, const float* gain, LAS float* scr, int kt, int ntile, int lane) {
    const int k0 = kt * 64, n0 = ntile * 64, nl = (lane & 15) * 4, n = n0 + nl;
    f32x4 v[16]; float gv[16];
#pragma unroll
    for (int i = 0; i < 16; ++i) { const int k = k0 + i * 4 + (lane >> 4); v[i] = (f32x4){0.f, 0.f, 0.f, 0.f}; gv[i] = 1.f;
        if (k < K && n < N) { v[i] = __builtin_nontemporal_load((const f32x4*)(W + (size_t)k * N + n)); if (gain) gv[i] = gain[k]; } }
#pragma unroll
    for (int i = 0; i < 16; ++i) { const int kl = i * 4 + (lane >> 4); const f32x4 x = v[i] * gv[i];
        LAS float* s = scr + kl * 65 + nl; s[0] = x.x; s[1] = x.y; s[2] = x.z; s[3] = x.w; }
    LDS_WAIT(); asm volatile("" ::: "memory");
    const int c = lane & 7;
#pragma unroll
    for (int j = 0; j < 8; ++j) { const int r = j * 8 + (lane >> 3); const LAS float* s = scr + (8 * c) * 65 + r;
        v4u o; o.x = pk2(s[0], s[65]); o.y = pk2(s[130], s[195]); o.z = pk2(s[260], s[325]); o.w = pk2(s[390], s[455]);
        *(GAS v4u*)(WT + (size_t)(n0 + r) * ldk + k0 + 8 * c) = o; }
    LDS_WAIT(); asm volatile("" ::: "memory");
}
constexpr int CONV_TOTAL = 32 * 2 + 32 * 2 + 32 * 4 + 2 * 4 * 32 + (LDZ0 / 64) * 64 + 64 * 64 + (FF / 64) * 64 + 64 * (FF / 64) + (LDZ1 / 64) * 64 + 64 * 64 + 64 * (FF / 64) + (FF / 64) * 64;
constexpr int CONV_P9 = 36864, CONV_P4 = 16384;
constexpr int G1_WGS = 224;
constexpr int CONV_P1 = 26624;
constexpr int CONV_A = CONV_TOTAL - CONV_P9 - CONV_P4, CONV_B = CONV_TOTAL - CONV_P9, CONV_A0 = CONV_A - CONV_P1;
static_assert(CONV_A0 >= 32 * 2 + 32 * 2 + 32 * 4 + 2 * 4 * 32 + (LDZ0 / 64) * 64, "the layer-0 projection weights are converted in the prologue");
static_assert(CONV_P9 <= 2 * 64 * (FF / 64) + 64 * 64 && CONV_P9 + CONV_P4 <= 3 * 64 * (FF / 64) + 64 * 64, "deferred ranges: mLSTM-phase items are layer-1 output / MLP weights; RG-LRU-phase items are needed after phase 4 (layer-0 down, layer-1 weights)");
__device__ __forceinline__ void conv_range(LAS unsigned char* lds, const CAS Args* a, int first, int last, int gw, int ngw, int wave, int lane) {
    unsigned char* ws = a->ws;
    LAS float* scr = (LAS float*)(lds + wave * 16640);
#define CONV(Wp, K_, N_, NPAD_, WTp, LDK_, GAIN_) { constexpr int ntn = (NPAD_) / 64, cnt = ntn * ((LDK_) / 64); \
        if (r < cnt) { conv_item(Wp, K_, N_, (bf16*)(WTp), LDK_, GAIN_, scr, r / ntn, r % ntn, lane); continue; } r -= cnt; }
    for (int it = first + gw; it < last; it += ngw) {
        int r = it;
        CONV(a->in[I_W2], 96, 2048, 2048, ws + WS_W2T, 128, (const float*)nullptr)
        CONV(a->in[I_A2], 96, 2048, 2048, ws + WS_A2T, 128, (const float*)nullptr)
        CONV(a->in[I_G2], 256, 2048, 2048, ws + WS_G2T, 256, (const float*)nullptr)
        CONV(a->in[I_WA], 2048, 256, 256, ws + WS_WAT, 2048, (const float*)nullptr)
        CONV(a->in[I_WX], 2048, 256, 256, ws + WS_WXT, 2048, (const float*)nullptr)
        CONV(a->in[I_HYIN], D, HY_IN, LDZ0, ws + WS_WHYIN, D, a->in[I_NMIX])
        CONV(a->in[I_HYOUT], D, D, D, ws + WS_WHYOUT, D, (const float*)nullptr)
        CONV(a->in[I_UP], D, FF, FF, ws + WS_WUP, D, a->in[I_NMLP])
        CONV(a->in[I_MLIN], D, ML_IN, LDZ1, ws + WS_WMLIN, D, a->in[I_NMIX] + D)
        CONV(a->in[I_DOWN], FF, D, D, ws + WS_WDOWN, FF, (const float*)nullptr)
        CONV(a->in[I_MLOUT], D, D, D, ws + WS_WMLOUT, D, (const float*)nullptr)
        CONV(a->in[I_DOWN] + (size_t)D * FF, FF, D, D, ws + WS_WDOWN + (size_t)FF * D * 2, FF, (const float*)nullptr)
        CONV(a->in[I_UP] + (size_t)D * FF, D, FF, FF, ws + WS_WUP + (size_t)FF * D * 2, D, a->in[I_NMLP] + D)
    }
#undef CONV
}
constexpr int CQ_BATCH = 64, CW_QUEUE = 16384;
__device__ __forceinline__ void conv_queue(LAS unsigned char* lds, const CAS Args* a, int first, int last, int q, int tid) {
    volatile LAS int* slot = (volatile LAS int*)(lds + MISC_OFF + 64);
    unsigned* ctr = (unsigned*)(a->ws + WS_CTL) + CW_QUEUE + 64 * q;
    const int wave = __builtin_amdgcn_readfirstlane(tid >> 6), lane = tid & 63;
    unsigned nxt = 0u;
    if (tid == 0) nxt = __hip_atomic_fetch_add(ctr, (unsigned)CQ_BATCH, __ATOMIC_RELAXED, __HIP_MEMORY_SCOPE_AGENT);
    __syncthreads();
    for (int it = 0;; ++it) {
        if (tid == 0) { slot[it & 1] = (int)nxt; nxt = __hip_atomic_fetch_add(ctr, (unsigned)CQ_BATCH, __ATOMIC_RELAXED, __HIP_MEMORY_SCOPE_AGENT); }
        LDS_WAIT(); __syncthreads();
        const int base = first + slot[it & 1];
        if (base >= last) break;
        conv_range(lds, a, base, (base + CQ_BATCH < last) ? base + CQ_BATCH : last, wave, NWAVES, wave, lane);
    }
}
__device__ __forceinline__ void p0_prologue(LAS unsigned char* lds, const CAS Args* a, int vcu, int wave, int lane) {
    unsigned char* ws = a->ws;
    const int gw = vcu * NWAVES + wave, NGW = GRID * NWAVES;
    conv_range(lds, a, 0, CONV_A0, gw, NGW, wave, lane);
    const float* x = a->in[I_X]; bf16* XB = (bf16*)(ws + WS_XB); float* SSQ = (float*)(ws + WS_SSQ);
    for (int m = gw; m < M; m += NGW) {
        const GAS f32x4* xr = (const GAS f32x4*)(x + (size_t)m * D) + lane; GAS v2u* o = (GAS v2u*)(XB + (size_t)m * D) + lane; float s = 0.f;
        f32x4 xv[16];
#pragma unroll
        for (int j = 0; j < 16; ++j) xv[j] = xr[64 * j];
#pragma unroll
        for (int j = 0; j < 16; ++j) { const f32x4 v = xv[j]; s += (v.x * v.x + v.y * v.y) + (v.z * v.z + v.w * v.w); v2u w; w.x = pk2(v.x, v.y); w.y = pk2(v.z, v.w); o[64 * j] = w; }
        s = wave_sum(s); if (lane == 0) SSQ[(size_t)m * 64] = s;
    }
}

template <class Sched> __device__ __forceinline__ void build_rs(LAS float* tab, const Sched& S, const float* ssq, int npart, int tid) {
    pg8::Unit u; int prev_pm = -1;
    for (int i = 0; i < 8 && S.next(i, u); ++i) {
        if (u.pm == prev_pm) { if ((tid & 1) == 0) tab[i * 256 + (tid >> 1)] = tab[(i - 1) * 256 + (tid >> 1)]; continue; }
        prev_pm = u.pm;
        const int row = u.pm * 256 + (tid >> 1), half = tid & 1; float s = 0.f;
        if (npart == 64) { const GAS f32x4* p = (const GAS f32x4*)(ssq + (size_t)row * 64 + half * 32);
#pragma unroll
            for (int k = 0; k < 8; ++k) { const f32x4 v = p[k]; s += (v.x + v.y) + (v.z + v.w); } }
        else if (half == 0) s = ((const GAS float*)ssq)[(size_t)row * 64];
        s += __shfl_xor(s, 1);
        if (half == 0) tab[i * 256 + (tid >> 1)] = 1.0f / sqrtf(s * (1.0f / D) + NORM_EPS);
    }
    LDS_WAIT(); __syncthreads();
}

typedef short s16x8_t __attribute__((ext_vector_type(8)));
typedef short s16x4_t __attribute__((ext_vector_type(4)));
#define MFMA16(a_, b_, c_) __builtin_amdgcn_mfma_f32_16x16x32_bf16(a_, b_, c_, 0, 0, 0)
__device__ __forceinline__ s16x4_t lds_tr4(const LAS bf16* p) { return __builtin_bit_cast(s16x4_t, __builtin_amdgcn_ds_read_tr16_b64_v4i16((LAS s16x4_t*)p)); }
__device__ __forceinline__ s16x8_t cat4(s16x4_t x, s16x4_t y) { return (s16x8_t){x[0], x[1], x[2], x[3], y[0], y[1], y[2], y[3]}; }
__device__ __forceinline__ void rwkv_prepass(const CAS Args* a, int gtid) {
    const bf16* Z = (const bf16*)(a->ws + WS_Z); bf16* AW = (bf16*)(a->ws + WS_AW); bf16* AAL = (bf16*)(a->ws + WS_AAL); bf16* AG = (bf16*)(a->ws + WS_AG);
    const float* mu = a->in[I_MU];
    static_assert(M * 64 == 4 * GRID * NTHR, "prepass: four tokens per thread");
    const int cg = gtid & 63, t0 = gtid >> 6;
    if (cg >= 56) { const int p = cg - 56;
#pragma unroll
        for (int k = 0; k < 4; ++k) { bf16* dst = (p < 4 ? AW : AAL) + (size_t)(t0 + 2048 * k) * 128 + 96 + (p & 3) * 8; *(GAS v4u*)dst = (v4u){0u, 0u, 0u, 0u}; } }
    else {
        const float* mp = mu + (ZC_WL - ZC_R) + cg * 8; const f32x4 m0 = *(const GAS f32x4*)mp, m1 = *(const GAS f32x4*)(mp + 4);
        const float mu8[8] = {m0[0], m0[1], m0[2], m0[3], m1[0], m1[1], m1[2], m1[3]};
        v4u zc[4], zp[4];
#pragma unroll
        for (int k = 0; k < 4; ++k) { const int t = t0 + 2048 * k; const bf16* zr = Z + (size_t)t * LDZ0 + ZC_WL + cg * 8;
            zc[k] = *(const GAS v4u*)zr; zp[k] = (v4u){0u, 0u, 0u, 0u}; if ((t & (SEQ - 1)) != 0) zp[k] = *(const GAS v4u*)(zr - LDZ0); }
#pragma unroll
        for (int k = 0; k < 4; ++k) { const int t = t0 + 2048 * k; float v[8];
#pragma unroll
            for (int e = 0; e < 4; ++e) { const float c0 = bflo(zc[k][e]), c1 = bfhi(zc[k][e]), p0 = bflo(zp[k][e]), p1 = bfhi(zp[k][e]);
                v[2 * e] = c0 + (p0 - c0) * mu8[2 * e]; v[2 * e + 1] = c1 + (p1 - c1) * mu8[2 * e + 1]; }
            bf16* dst;
            if (cg < 12) { dst = AW + (size_t)t * 128 + cg * 8;
#pragma unroll
                for (int e = 0; e < 8; ++e) v[e] = ftanh(v[e]); }
            else if (cg < 24) { dst = AAL + (size_t)t * 128 + (cg - 12) * 8; }
            else { dst = AG + (size_t)t * 256 + (cg - 24) * 8;
#pragma unroll
                for (int e = 0; e < 8; ++e) v[e] = fsigmoid(v[e]); }
            v4u o; o.x = pk2(v[0], v[1]); o.y = pk2(v[2], v[3]); o.z = pk2(v[4], v[5]); o.w = pk2(v[6], v[7]);
            *(GAS v4u*)dst = o; }
    }
}

struct RwkvRaw { v4u zr, zrp, zk, zkp, zv, zvp, d, a, g; };
__device__ __forceinline__ void rwkv_load(RwkvRaw& R, const bf16* Z, const bf16* DEC, const bf16* AAp, const bf16* GG, int b, int h, int j, int ltt, int lcc) {
    const int tpos = j * 64 + ltt; const size_t g = (size_t)b * SEQ + tpos; const int c0 = h * 64 + lcc * 8;
    const bf16* zrow = Z + g * LDZ0 + c0;
    R.zr = *(const GAS v4u*)(zrow + ZC_R); R.zk = *(const GAS v4u*)(zrow + ZC_K); R.zv = *(const GAS v4u*)(zrow + ZC_V);
    if (tpos > 0) { R.zrp = *(const GAS v4u*)(zrow + ZC_R - LDZ0); R.zkp = *(const GAS v4u*)(zrow + ZC_K - LDZ0); R.zvp = *(const GAS v4u*)(zrow + ZC_V - LDZ0); }
    else { R.zrp = (v4u){0u, 0u, 0u, 0u}; R.zkp = R.zrp; R.zvp = R.zrp; }
    R.d = *(const GAS v4u*)(DEC + g * 2048 + c0); R.a = *(const GAS v4u*)(AAp + g * 2048 + c0); R.g = *(const GAS v4u*)(GG + g * 2048 + c0);
}
constexpr int RW_TS = 72;
__device__ __forceinline__ v4u pack8(const float (&x)[8]) { v4u o; o.x = pk2(x[0], x[1]); o.y = pk2(x[2], x[3]); o.z = pk2(x[4], x[5]); o.w = pk2(x[6], x[7]); return o; }
__device__ __forceinline__ void rwkv_phase(LAS unsigned char* lds, const CAS Args* a, int bh, int tid) {
    LAS bf16* KAP = (LAS bf16*)lds; LAS bf16* RHAT = KAP + 64 * RW_TS; LAS bf16* KHAT = RHAT + 64 * RW_TS; LAS bf16* AHAT = KHAT + 64 * RW_TS; LAS bf16* VB = AHAT + 64 * RW_TS;
    LAS float* LW = (LAS float*)(VB + 64 * RW_TS);
    LAS float* YY = LW + 4096;
    LAS float* LA = YY + 4096;
    LAS bf16* LK = (LAS bf16*)(LA + 1024);
    LAS bf16* UINV = LK + 1024; LAS bf16* G3M = UINV + 1024; LAS bf16* G4M = G3M + 1024;
    LAS float* GT = (LAS float*)(G4M + 1024);
    LAS float* BD = GT + 256;
    LAS float* PRM = BD + 64;
    const bf16* Z = (const bf16*)(a->ws + WS_Z); const bf16* DEC = (const bf16*)(a->ws + WS_DEC); const bf16* AAp = (const bf16*)(a->ws + WS_AA); const bf16* GG = (const bf16*)(a->ws + WS_GG);
    bf16* CAT = (bf16*)(a->ws + WS_CAT);
    const float* mu = a->in[I_MU]; const float* k_k = a->in[I_KK]; const float* k_a = a->in[I_KA]; const float* r_k = a->in[I_RK]; const float* ln_w = a->in[I_LNW]; const float* ln_b = a->in[I_LNB];
    const int b = bh >> 5, h = bh & 31, lane = tid & 63, wave = __builtin_amdgcn_readfirstlane(tid >> 6);
    const int ltt = tid >> 3, lcc = tid & 7, c0 = h * 64 + lcc * 8;
    const int i = lane & 15, g = lane >> 4, q4 = i >> 2, p4 = i & 3;
    const s16x4_t z4 = (s16x4_t){0, 0, 0, 0};
    f32x4 X[4];
#pragma unroll
    for (int t = 0; t < 4; ++t) X[t] = (f32x4){0.f, 0.f, 0.f, 0.f};
    RwkvRaw R; rwkv_load(R, Z, DEC, AAp, GG, b, h, 0, ltt, lcc);
    { const int p = tid >> 6, cc = h * 64 + (tid & 63);
      PRM[tid] = (p < 3) ? mu[p * 2048 + cc] : (p == 3) ? k_k[cc] : (p == 4) ? k_a[cc] : (p == 5) ? r_k[cc] : (p == 6) ? ln_w[cc] : ln_b[cc]; }
    LDS_WAIT(); __syncthreads();
    for (int j = 0; j < SEQ / 64; ++j) {
        const v4u gk = R.g;
        float rs[8], kkr[8], kt[8], ka[8], vs[8], lwv[8];
        {
            float ks[8], av[8], mur[8], muk[8], muv[8], pkk[8], pka[8], prk[8];
#pragma unroll
            for (int x = 0; x < 8; x += 4) { const LAS float* pp = PRM + lcc * 8 + x;
                const f32x4 a0 = *(const LAS f32x4*)pp, a1 = *(const LAS f32x4*)(pp + 64), a2 = *(const LAS f32x4*)(pp + 128), a3 = *(const LAS f32x4*)(pp + 192), a4 = *(const LAS f32x4*)(pp + 256), a5 = *(const LAS f32x4*)(pp + 320);
#pragma unroll
                for (int y = 0; y < 4; ++y) { mur[x + y] = a0[y]; muk[x + y] = a1[y]; muv[x + y] = a2[y]; pkk[x + y] = a3[y]; pka[x + y] = a4[y]; prk[x + y] = a5[y]; } }
#pragma unroll
            for (int e = 0; e < 4; ++e) {
                float c, p;
                c = bflo(R.zr[e]); p = bflo(R.zrp[e]); rs[2 * e] = c + (p - c) * mur[2 * e];
                c = bfhi(R.zr[e]); p = bfhi(R.zrp[e]); rs[2 * e + 1] = c + (p - c) * mur[2 * e + 1];
                c = bflo(R.zk[e]); p = bflo(R.zkp[e]); ks[2 * e] = c + (p - c) * muk[2 * e];
                c = bfhi(R.zk[e]); p = bfhi(R.zkp[e]); ks[2 * e + 1] = c + (p - c) * muk[2 * e + 1];
                c = bflo(R.zv[e]); p = bflo(R.zvp[e]); vs[2 * e] = c + (p - c) * muv[2 * e];
                c = bfhi(R.zv[e]); p = bfhi(R.zvp[e]); vs[2 * e + 1] = c + (p - c) * muv[2 * e + 1];
            }
#pragma unroll
            for (int e = 0; e < 4; ++e) { av[2 * e] = bflo(R.a[e]); av[2 * e + 1] = bfhi(R.a[e]); lwv[2 * e] = bflo(R.d[e]); lwv[2 * e + 1] = bfhi(R.d[e]); }
            float q = 0.f;
#pragma unroll
            for (int e = 0; e < 8; ++e) { kkr[e] = ks[e] * pkk[e]; q += kkr[e] * kkr[e]; }
            q = red8(q);
            const float inv = 1.0f / fmaxf(sqrtf(q), 1e-12f);
            float bd = 0.f;
#pragma unroll
            for (int e = 0; e < 8; ++e) { kkr[e] *= inv; kt[e] = ks[e] * (1.f + (av[e] - 1.f) * pka[e]); ka[e] = kkr[e] * av[e]; bd += rs[e] * kt[e] * prk[e]; }
            bd = red8(bd);
            *(LAS f32x4*)(LW + ltt * 64 + lcc * 8) = (f32x4){lwv[0], lwv[1], lwv[2], lwv[3]}; *(LAS f32x4*)(LW + ltt * 64 + lcc * 8 + 4) = (f32x4){lwv[4], lwv[5], lwv[6], lwv[7]};
            if (lcc == 0) BD[ltt] = bd;
        }
        LDS_WAIT(); __syncthreads();
        if (j + 1 < SEQ / 64) rwkv_load(R, Z, DEC, AAp, GG, b, h, j + 1, ltt, lcc);
        if (tid < 256) { LAS float* p = LW + (tid >> 6) * 1024 + (tid & 63); float x[16], acc = 0.f;
#pragma unroll
            for (int s = 0; s < 16; ++s) x[s] = p[s * 64];
#pragma unroll
            for (int s = 0; s < 16; ++s) { p[s * 64] = acc; acc += x[s]; } }
        LDS_WAIT(); __syncthreads();
        {
            const int sc = ltt >> 4, tl = ltt & 15;
            const f32x4 l0 = *(const LAS f32x4*)(LW + ltt * 64 + lcc * 8), l1 = *(const LAS f32x4*)(LW + ltt * 64 + lcc * 8 + 4);
            const float lgm[8] = {l0[0], l0[1], l0[2], l0[3], l1[0], l1[1], l1[2], l1[3]};
            float o0[8], o1[8], o2[8], o3[8], egl[8];
#pragma unroll
            for (int e = 0; e < 8; ++e) { const float em = fexp2(lgm[e]), el = em * fexp2(lwv[e]), iv = frcp(el);
                o0[e] = kkr[e] * em; o1[e] = rs[e] * el; o2[e] = kt[e] * iv; o3[e] = ka[e] * iv; egl[e] = el; }
            const int o = ltt * RW_TS + lcc * 8;
            *(LAS v4u*)(KAP + o) = pack8(o0); *(LAS v4u*)(RHAT + o) = pack8(o1); *(LAS v4u*)(KHAT + o) = pack8(o2); *(LAS v4u*)(AHAT + o) = pack8(o3); *(LAS v4u*)(VB + o) = pack8(vs);
            if (tl == 15) { *(LAS f32x4*)(GT + sc * 64 + lcc * 8) = (f32x4){egl[0], egl[1], egl[2], egl[3]}; *(LAS f32x4*)(GT + sc * 64 + lcc * 8 + 4) = (f32x4){egl[4], egl[5], egl[6], egl[7]}; }
        }
        LDS_WAIT(); __syncthreads();
        if (wave < 4) {
            const int sc = wave; const LAS bf16* kap = KAP + 16 * sc * RW_TS + i * RW_TS + 8 * g; const LAS bf16* rha = RHAT + 16 * sc * RW_TS + i * RW_TS + 8 * g;
            const LAS bf16* kha = KHAT + 16 * sc * RW_TS + i * RW_TS + 8 * g; const LAS bf16* aha = AHAT + 16 * sc * RW_TS + i * RW_TS + 8 * g;
            f32x4 g1 = (f32x4){0.f, 0.f, 0.f, 0.f}, g2 = g1, g3 = g1, g4 = g1;
#pragma unroll
            for (int ks = 0; ks < 2; ++ks) { const s16x8_t fa = *(const LAS s16x8_t*)(kap + 32 * ks), fr = *(const LAS s16x8_t*)(rha + 32 * ks), fk = *(const LAS s16x8_t*)(kha + 32 * ks), fh = *(const LAS s16x8_t*)(aha + 32 * ks);
                g1 = MFMA16(fa, fh, g1); g2 = MFMA16(fa, fk, g2); g3 = MFMA16(fr, fk, g3); g4 = MFMA16(fr, fh, g4); }
            { f32x4 lt4;
#pragma unroll
              for (int r = 0; r < 4; ++r) { const int t = 4 * g + r, o = sc * 256 + t * 16 + i; const bool lo = i < t, le = i <= t;
                lt4[r] = lo ? g1[r] : 0.f; LK[o] = (bf16)f2bf(lo ? g2[r] : 0.f); G3M[o] = (bf16)f2bf(le ? g3[r] : 0.f); G4M[o] = (bf16)f2bf(le ? g4[r] : 0.f); }
              *(LAS f32x4*)(LA + sc * 256 + i * 16 + 4 * g) = lt4; }
            LDS_WAIT(); asm volatile("" ::: "memory");
            float x[16];
#pragma unroll
            for (int t = 0; t < 16; ++t) x[t] = (i == t) ? 1.f : 0.f;
#pragma unroll
            for (int s2 = 0; s2 < 15; ++s2) {
#pragma unroll
                for (int t4 = (s2 + 1) & ~3; t4 < 16; t4 += 4) { const f32x4 l4 = *(const LAS f32x4*)(LA + sc * 256 + s2 * 16 + t4);
#pragma unroll
                    for (int e = 0; e < 4; ++e) if (t4 + e > s2) x[t4 + e] -= l4[e] * x[s2]; } }
            if (g == 0) {
#pragma unroll
                for (int t = 0; t < 16; ++t) UINV[sc * 256 + t * 16 + i] = (bf16)f2bf(x[t]); }
        }
        LDS_WAIT(); __syncthreads();
        if (wave < 4) {
            const int jv = wave;
#pragma unroll 2
            for (int sc = 0; sc < 4; ++sc) {
                const int r0 = 16 * sc;
                v4u xw0, xw1;
                xw0.x = pk2(X[0][0], X[0][1]); xw0.y = pk2(X[0][2], X[0][3]); xw0.z = pk2(X[1][0], X[1][1]); xw0.w = pk2(X[1][2], X[1][3]);
                xw1.x = pk2(X[2][0], X[2][1]); xw1.y = pk2(X[2][2], X[2][3]); xw1.z = pk2(X[3][0], X[3][1]); xw1.w = pk2(X[3][2], X[3][3]);
                const s16x8_t xb0 = __builtin_bit_cast(s16x8_t, xw0), xb1 = __builtin_bit_cast(s16x8_t, xw1);
                const s16x8_t vf = cat4(lds_tr4(VB + (r0 + 4 * g + q4) * RW_TS + 16 * jv + 4 * p4), z4);
                const int so = sc * 256 + i * 16 + 4 * g;
                f32x4 accB = MFMA16(cat4(*(const LAS s16x4_t*)(LK + so), z4), vf, ((f32x4){0.f, 0.f, 0.f, 0.f}));
                f32x4 accY = MFMA16(cat4(*(const LAS s16x4_t*)(G3M + so), z4), vf, ((f32x4){0.f, 0.f, 0.f, 0.f}));
                { const LAS bf16* kp = KAP + (r0 + i) * RW_TS + 4 * g; const LAS bf16* rp = RHAT + (r0 + i) * RW_TS + 4 * g;
                  accB = MFMA16(cat4(*(const LAS s16x4_t*)kp, *(const LAS s16x4_t*)(kp + 16)), xb0, accB); accB = MFMA16(cat4(*(const LAS s16x4_t*)(kp + 32), *(const LAS s16x4_t*)(kp + 48)), xb1, accB);
                  accY = MFMA16(cat4(*(const LAS s16x4_t*)rp, *(const LAS s16x4_t*)(rp + 16)), xb0, accY); accY = MFMA16(cat4(*(const LAS s16x4_t*)(rp + 32), *(const LAS s16x4_t*)(rp + 48)), xb1, accY); }
#pragma unroll
                for (int kt4 = 0; kt4 < 4; ++kt4) X[kt4] = MFMA16(cat4(lds_tr4(KHAT + (r0 + 4 * g + q4) * RW_TS + 16 * kt4 + 4 * p4), z4), vf, X[kt4]);
                v4u bw; bw.x = pk2(accB[0], accB[1]); bw.y = pk2(accB[2], accB[3]); bw.z = 0u; bw.w = 0u;
                const f32x4 accU = MFMA16(cat4(*(const LAS s16x4_t*)(UINV + so), z4), __builtin_bit_cast(s16x8_t, bw), ((f32x4){0.f, 0.f, 0.f, 0.f}));
                v4u uw; uw.x = pk2(-accU[0], -accU[1]); uw.y = pk2(-accU[2], -accU[3]); uw.z = 0u; uw.w = 0u;
                const s16x8_t unf = __builtin_bit_cast(s16x8_t, uw);
                accY = MFMA16(cat4(*(const LAS s16x4_t*)(G4M + so), z4), unf, accY);
#pragma unroll
                for (int kt4 = 0; kt4 < 4; ++kt4) { X[kt4] = MFMA16(cat4(lds_tr4(AHAT + (r0 + 4 * g + q4) * RW_TS + 16 * kt4 + 4 * p4), z4), unf, X[kt4]);
                    X[kt4] = X[kt4] * *(const LAS f32x4*)(GT + sc * 64 + 16 * kt4 + 4 * g); }
#pragma unroll
                for (int r = 0; r < 4; ++r) YY[(r0 + 4 * g + r) * 64 + 16 * jv + i] = accY[r];
            }
        }
        LDS_WAIT(); __syncthreads();
        {
            const int o = ltt * 64 + lcc * 8; const size_t gt = (size_t)b * SEQ + j * 64 + ltt;
            const f32x4 ya = *(const LAS f32x4*)(YY + o), yb = *(const LAS f32x4*)(YY + o + 4); const v4u vw = *(const LAS v4u*)(VB + ltt * RW_TS + lcc * 8);
            float y[8] = {ya[0], ya[1], ya[2], ya[3], yb[0], yb[1], yb[2], yb[3]};
            float vq[8] = {bflo(vw[0]), bfhi(vw[0]), bflo(vw[1]), bfhi(vw[1]), bflo(vw[2]), bfhi(vw[2]), bflo(vw[3]), bfhi(vw[3])};
            float gq[8] = {bflo(gk[0]), bfhi(gk[0]), bflo(gk[1]), bfhi(gk[1]), bflo(gk[2]), bfhi(gk[2]), bflo(gk[3]), bfhi(gk[3])};
            float s = 0.f;
#pragma unroll
            for (int e = 0; e < 8; ++e) s += y[e];
            const float mean = red8(s) * (1.f / 64.f); float q = 0.f;
#pragma unroll
            for (int e = 0; e < 8; ++e) { y[e] -= mean; q += y[e] * y[e]; }
            const float rstd = 1.0f / sqrtf(red8(q) * (1.f / 64.f) + GN_EPS), bd = BD[ltt];
            const LAS float* lp = PRM + 384 + lcc * 8; const f32x4 w0 = *(const LAS f32x4*)lp, w1 = *(const LAS f32x4*)(lp + 4), b0 = *(const LAS f32x4*)(lp + 64), b1 = *(const LAS f32x4*)(lp + 68);
            const float lw8[8] = {w0[0], w0[1], w0[2], w0[3], w1[0], w1[1], w1[2], w1[3]}, lb8[8] = {b0[0], b0[1], b0[2], b0[3], b1[0], b1[1], b1[2], b1[3]};
            float ov[8];
#pragma unroll
            for (int e = 0; e < 8; ++e) ov[e] = (y[e] * rstd * lw8[e] + lb8[e] + bd * vq[e]) * gq[e];
            *(GAS v4u*)(CAT + gt * D + 2048 + c0) = pack8(ov);
        }
        LDS_WAIT(); __syncthreads();
    }
}

constexpr int ML_QS = 264, ML_VS = 136, ML_PS = 72;
constexpr int ML_KS = 272, ML_VGS = 144, ML_QP = 272;
__device__ __forceinline__ void ml_scalars(LAS float* SC, int lane, float& mprev) {
    const float li = SC[lane], lf = SC[64 + lane];
    const float b = scan_add64(lf);
    const float gq = li - b, mx = scan_max64(gq);
    const float mm = fmaxf(mx, mprev);
    SC[128 + lane] = -mm; SC[192 + lane] = gq; SC[256 + lane] = expf(mprev - mm); SC[384 + lane] = expf(-(b + mm));
    const float blast = lane63(b), mlast = lane63(mx);
    const float mnew = fmaxf(blast + mprev, blast + mlast);
    SC[320 + lane] = expf(blast + gq - mnew);
    if (lane == 0) SC[448] = expf(blast + mprev - mnew);
    mprev = mnew;
}
struct MlRaw { v4u q[4], k[4], v[2]; float gi, gf; };
template <bool WITH_V> __device__ __forceinline__ void ml_load(MlRaw& R, const bf16* Z, const float* ZG, int b, int h, int dvs, int c, int row, int seg) {
    const int tid_ = row * 8 + seg;
    const bf16* z0 = Z + ((size_t)b * SEQ + c * 64) * LDZ1;
#pragma unroll
    for (int e = 0; e < 4; ++e) { const bf16* zr = z0 + (size_t)((tid_ >> 5) + 16 * e) * LDZ1 + h * 256 + (tid_ & 31) * 8; R.q[e] = *(const GAS v4u*)(zr + MC_Q); R.k[e] = *(const GAS v4u*)(zr + MC_K); }
    if (WITH_V) {
#pragma unroll
        for (int e = 0; e < 2; ++e) R.v[e] = *(const GAS v4u*)(z0 + (size_t)((tid_ >> 4) + 32 * e) * LDZ1 + MC_V + h * 512 + dvs * 128 + (tid_ & 15) * 8); }
    { const float* zp = ZG + (size_t)seg * M * 16 + ((size_t)b * SEQ + c * 64 + row) * 16 + h;
      R.gi = *(const GAS float*)zp; R.gf = *(const GAS float*)(zp + 8); }
}
template <int QP, int KP, bool QPERM> __device__ __forceinline__ f32x4 ml_s_tile(const LAS bf16* Qs, const LAS bf16* Ks, int lt, int st, int i, int g) {
    f32x4 acc = (f32x4){0.f, 0.f, 0.f, 0.f};
    const LAS bf16* qa = Qs + (16 * lt + i) * QP + 8 * g; const LAS bf16* kb = Ks + (16 * st + i) * KP + (QPERM ? 4 * g : 8 * g);
#pragma unroll
    for (int ks = 0; ks < 8; ++ks) acc = MFMA16(*(const LAS s16x8_t*)(qa + 32 * ks), QPERM ? cat4(*(const LAS s16x4_t*)(kb + 32 * ks), *(const LAS s16x4_t*)(kb + 32 * ks + 16)) : *(const LAS s16x8_t*)(kb + 32 * ks), acc);
    return acc;
}
__device__ __forceinline__ void mlstm_num_phase(LAS unsigned char* lds, const CAS Args* a, int w, int tid) {
    LAS bf16* Qs = (LAS bf16*)lds;
    LAS bf16* Ks = Qs + 64 * ML_QP;
    LAS bf16* Vs = Ks + 64 * ML_KS;
    LAS bf16* VGs = Vs + 64 * ML_VS;
    LAS bf16* Ps = VGs + 64 * ML_VGS;
    LAS float* SC = (LAS float*)(Ps + 64 * ML_PS);
    static_assert((64 * ML_QP + 64 * ML_KS + 2 * 64 * ML_VS + 64 * ML_VGS + 64 * ML_PS) * 2 + 2048 <= LDSCTL_OFF, "mLSTM numerator LDS map");
    LAS bf16* Os = (LAS bf16*)(SC + 512);
    const bf16* Z = (const bf16*)(a->ws + WS_Z); const float* ZG = (const float*)(a->ws + WS_ZP); bf16* NUM = (bf16*)(a->ws + WS_HRAW);
    const int bh = w >> 2, dvs = w & 3, b = bh >> 3, h = bh & 7, lane = tid & 63, wave = __builtin_amdgcn_readfirstlane(tid >> 6);
    const int row = tid >> 3, seg = tid & 7;
    const int i = lane & 15, g = lane >> 4, q4 = i >> 2, p4 = i & 3, dv0 = 16 * wave;
    const float bi = a->in[I_BI][h], bfv = a->in[I_BF][h];
    f32x4 C[16];
#pragma unroll
    for (int t = 0; t < 16; ++t) C[t] = (f32x4){0.f, 0.f, 0.f, 0.f};
    float mprev = 0.f;
    MlRaw R; ml_load<true>(R, Z, ZG, b, h, dvs, 0, row, seg);
    for (int c = 0; c < SEQ / 64; ++c) {
        __syncthreads();
#pragma unroll
        for (int e = 0; e < 4; ++e) { const int ch = tid & 31; LAS bf16* qd = Qs + ((tid >> 5) + 16 * e) * ML_QP + 32 * (ch >> 2) + 16 * (ch & 1) + 4 * ((ch >> 1) & 1);
            *(LAS v2u*)qd = (v2u){R.q[e].x, R.q[e].y}; *(LAS v2u*)(qd + 8) = (v2u){R.q[e].z, R.q[e].w};
            *(LAS v4u*)(Ks + ((tid >> 5) + 16 * e) * ML_KS + (tid & 31) * 8) = R.k[e]; }
#pragma unroll
        for (int e = 0; e < 2; ++e) *(LAS v4u*)(Vs + ((tid >> 4) + 32 * e) * ML_VS + (tid & 15) * 8) = R.v[e];
        { const float gi = red8(R.gi), gf = red8(R.gf); if (seg == 0) { SC[row] = gi + bi; SC[64 + row] = flogsig(gf + bfv); } }
        const v4u vk0 = R.v[0], vk1 = R.v[1];
        if (c + 1 < SEQ / 64) ml_load<true>(R, Z, ZG, b, h, dvs, c + 1, row, seg);
        if (c > 0) { const LAS v4u* op = (const LAS v4u*)(Os + row * ML_VS + seg * 16); const v4u o0 = op[0], o1 = op[1];
            GAS v4u* gp = (GAS v4u*)(NUM + ((size_t)b * SEQ + (c - 1) * 64 + row) * D + h * 512 + dvs * 128 + seg * 16); gp[0] = o0; gp[1] = o1; }
        LDS_WAIT(); __syncthreads();
        if (wave == 0) ml_scalars(SC, lane, mprev);
        LDS_WAIT(); __syncthreads();
#pragma unroll
        for (int e = 0; e < 2; ++e) { const int vr = (tid >> 4) + 32 * e; const float gw = SC[320 + vr]; const v4u vv = e ? vk1 : vk0; v4u o;
#pragma unroll
            for (int x = 0; x < 4; ++x) o[x] = pk2(bflo(vv[x]) * gw, bfhi(vv[x]) * gw);
            *(LAS v4u*)(VGs + vr * ML_VGS + (tid & 15) * 8) = o; }
        { const int lt = wave >> 1;
#pragma unroll
          for (int hh = 0; hh < 2; ++hh) { const int st = 2 * (wave & 1) + hh;
              f32x4 pv = (f32x4){0.f, 0.f, 0.f, 0.f};
              if (st <= lt) { const f32x4 acc = ml_s_tile<ML_QP, ML_KS, true>(Qs, Ks, lt, st, i, g); const f32x4 rt = *(const LAS f32x4*)(SC + 128 + 16 * lt + 4 * g); const float ct = SC[192 + 16 * st + i];
#pragma unroll
                  for (int r = 0; r < 4; ++r) pv[r] = (16 * st + i <= 16 * lt + 4 * g + r) ? acc[r] * 0.0625f * fexp2(1.4426950408889634f * (rt[r] + ct)) : 0.f; }
#pragma unroll
              for (int r = 0; r < 4; ++r) Ps[(16 * lt + 4 * g + r) * ML_PS + 16 * st + i] = (bf16)f2bf(pv[r]); } }
        LDS_WAIT(); __syncthreads();
        f32x4 nA[4], nB[4];
#pragma unroll
        for (int lt = 0; lt < 4; ++lt) { nA[lt] = (f32x4){0.f, 0.f, 0.f, 0.f}; nB[lt] = (f32x4){0.f, 0.f, 0.f, 0.f}; }
#pragma unroll
        for (int ks = 0; ks < 2; ++ks) { const LAS bf16* vp = Vs + (32 * ks + 8 * g + q4) * ML_VS + dv0 + 4 * p4;
            const s16x8_t bv = cat4(lds_tr4(vp), lds_tr4(vp + 4 * ML_VS));
#pragma unroll
            for (int lt = 0; lt < 4; ++lt) nA[lt] = MFMA16(*(const LAS s16x8_t*)(Ps + (16 * lt + i) * ML_PS + 32 * ks + 8 * g), bv, nA[lt]); }
        { s16x8_t qa[3][4];
#define ML_LDQ(dst, KS) _Pragma("unroll") for (int lt = 0; lt < 4; ++lt) dst[lt] = *(const LAS s16x8_t*)(Qs + (16 * lt + i) * ML_QP + 32 * (KS) + 8 * g);
          ML_LDQ(qa[0], 0) ML_LDQ(qa[1], 1)
          __builtin_amdgcn_sched_barrier(0);
#pragma unroll
          for (int ks = 0; ks < 8; ++ks) {
              if (ks + 2 < 8) { ML_LDQ(qa[(ks + 2) % 3], ks + 2) }
              v4u cw; cw.x = pk2(C[2 * ks][0], C[2 * ks][1]); cw.y = pk2(C[2 * ks][2], C[2 * ks][3]); cw.z = pk2(C[2 * ks + 1][0], C[2 * ks + 1][1]); cw.w = pk2(C[2 * ks + 1][2], C[2 * ks + 1][3]);
              const s16x8_t bc = __builtin_bit_cast(s16x8_t, cw);
#pragma unroll
              for (int lt = 0; lt < 4; ++lt) nB[lt] = MFMA16(qa[ks % 3][lt], bc, nB[lt]);
              __builtin_amdgcn_sched_barrier(0);
          }
#undef ML_LDQ
        }
        { s16x8_t ka[3][4], bv[2];
#define ML_LDK(dst, BQ) _Pragma("unroll") for (int u = 0; u < 4; ++u) { const LAS bf16* kp = Ks + (32 * ((BQ) >> 2) + 4 * g + q4) * ML_KS + 4 * p4 + 16 * (4 * ((BQ) & 3) + u); dst[u] = cat4(lds_tr4(kp), lds_tr4(kp + 16 * ML_KS)); }
          f32x4 it4[4];
#pragma unroll
          for (int lt = 0; lt < 4; ++lt) it4[lt] = *(const LAS f32x4*)(SC + 256 + 16 * lt + 4 * g);
          const float cd = SC[448];
#pragma unroll
          for (int ks = 0; ks < 2; ++ks) { const LAS bf16* vp = VGs + (32 * ks + 4 * g + q4) * ML_VGS + dv0 + 4 * p4; bv[ks] = cat4(lds_tr4(vp), lds_tr4(vp + 16 * ML_VGS)); }
          ML_LDK(ka[0], 0) ML_LDK(ka[1], 1)
          __builtin_amdgcn_sched_barrier(0);
#pragma unroll
          for (int lt = 0; lt < 4; ++lt) {
#pragma unroll
              for (int r = 0; r < 4; ++r) Os[(16 * lt + 4 * g + r) * ML_VS + dv0 + i] = (bf16)f2bf(nA[lt][r] + it4[lt][r] * 0.0625f * nB[lt][r]); }
#pragma unroll
          for (int t = 0; t < 16; ++t) C[t] = C[t] * cd;
          __builtin_amdgcn_sched_barrier(0);
#pragma unroll
          for (int bq = 0; bq < 8; ++bq) {
              if (bq + 2 < 8) { ML_LDK(ka[(bq + 2) % 3], bq + 2) }
#pragma unroll
              for (int u = 0; u < 4; ++u) C[4 * (bq & 3) + u] = MFMA16(ka[bq % 3][u], bv[bq >> 2], C[4 * (bq & 3) + u]);
              __builtin_amdgcn_sched_barrier(0);
          }
#undef ML_LDK
        }
    }
    LDS_WAIT(); __syncthreads();
    { const LAS v4u* op = (const LAS v4u*)(Os + row * ML_VS + seg * 16); const v4u o0 = op[0], o1 = op[1];
      GAS v4u* gp = (GAS v4u*)(NUM + ((size_t)b * SEQ + (SEQ - 64) + row) * D + h * 512 + dvs * 128 + seg * 16); gp[0] = o0; gp[1] = o1; }
}
__device__ __forceinline__ void mlstm_den_phase(LAS unsigned char* lds, const CAS Args* a, int bh, int tid) {
    LAS bf16* Qs = (LAS bf16*)lds; LAS bf16* Ks = Qs + 64 * ML_QS;
    LAS float* SC = (LAS float*)(Ks + 64 * ML_QS);
    LAS float* NS = SC + 512;
    LAS float* NP = NS + 256;
    LAS float* ROWP = NP + 512;
    LAS float* QN = ROWP + 256;
    const bf16* Z = (const bf16*)(a->ws + WS_Z); const float* ZG = (const float*)(a->ws + WS_ZP); float* DENG = (float*)(a->ws + WS_HSSQ); float* EMTG = DENG + (size_t)M * 8;
    const int b = bh >> 3, h = bh & 7, lane = tid & 63, wave = __builtin_amdgcn_readfirstlane(tid >> 6);
    const int row = tid >> 3, seg = tid & 7, i = lane & 15, g = lane >> 4;
    const float bi = a->in[I_BI][h], bfv = a->in[I_BF][h];
    if (tid < 256) NS[tid] = 0.f;
    float mprev = 0.f;
    MlRaw R; ml_load<false>(R, Z, ZG, b, h, 0, 0, row, seg);
    for (int c = 0; c < SEQ / 64; ++c) {
        __syncthreads();
#pragma unroll
        for (int e = 0; e < 4; ++e) { *(LAS v4u*)(Qs + ((tid >> 5) + 16 * e) * ML_QS + (tid & 31) * 8) = R.q[e]; *(LAS v4u*)(Ks + ((tid >> 5) + 16 * e) * ML_QS + (tid & 31) * 8) = R.k[e]; }
        { const float gi = red8(R.gi), gf = red8(R.gf); if (seg == 0) { SC[row] = gi + bi; SC[64 + row] = flogsig(gf + bfv); } }
        if (c + 1 < SEQ / 64) ml_load<false>(R, Z, ZG, b, h, 0, c + 1, row, seg);
        LDS_WAIT(); __syncthreads();
        if (wave == 0) ml_scalars(SC, lane, mprev);
        LDS_WAIT(); __syncthreads();
        { const int lt = wave >> 1;
#pragma unroll
          for (int hh = 0; hh < 2; ++hh) { const int st = 2 * (wave & 1) + hh;
              f32x4 pv = (f32x4){0.f, 0.f, 0.f, 0.f};
              if (st <= lt) { const f32x4 acc = ml_s_tile<ML_QS, ML_QS, false>(Qs, Ks, lt, st, i, g); const f32x4 rt = *(const LAS f32x4*)(SC + 128 + 16 * lt + 4 * g); const float ct = SC[192 + 16 * st + i];
#pragma unroll
                  for (int r = 0; r < 4; ++r) pv[r] = (16 * st + i <= 16 * lt + 4 * g + r) ? bf2f((bf16)f2bf(acc[r] * 0.0625f * fexp2(1.4426950408889634f * (rt[r] + ct)))) : 0.f; }
#pragma unroll
              for (int r = 0; r < 4; ++r) { const float s = red16(pv[r]); if (i == 0) ROWP[st * 64 + 16 * lt + 4 * g + r] = s; } } }
        { float acc = 0.f; const LAS bf16* qp = Qs + row * ML_QS + seg * 32; const LAS float* np = NS + seg * 32;
#pragma unroll
          for (int e = 0; e < 4; ++e) { const v4u qw = *(const LAS v4u*)(qp + 8 * e);
#pragma unroll
              for (int x = 0; x < 4; ++x) acc += bflo(qw[x]) * np[8 * e + 2 * x] + bfhi(qw[x]) * np[8 * e + 2 * x + 1]; }
          acc = red8(acc); if (seg == 0) QN[row] = acc; }
        LDS_WAIT(); __syncthreads();
        if (tid < 64) { const size_t t = (size_t)b * SEQ + c * 64 + tid;
            const float den = ((ROWP[tid] + ROWP[64 + tid]) + (ROWP[128 + tid] + ROWP[192 + tid])) + SC[256 + tid] * 0.0625f * QN[tid];
            DENG[t * 8 + h] = den; EMTG[t * 8 + h] = SC[384 + tid]; }
        { const int d = tid & 255, hf = tid >> 8; float acc = 0.f;
#pragma unroll 8
          for (int s = 0; s < 32; ++s) acc += bf2f(Ks[(hf * 32 + s) * ML_QS + d]) * SC[320 + hf * 32 + s];
          NP[hf * 256 + d] = acc; }
        LDS_WAIT(); __syncthreads();
        if (tid < 256) NS[tid] = SC[448] * NS[tid] + (NP[tid] + NP[256 + tid]);
    }
}
__device__ __forceinline__ void mlstm_post(const CAS Args* a, int gwave, int lane) {
    const bf16* Z = (const bf16*)(a->ws + WS_Z); const bf16* NUM = (const bf16*)(a->ws + WS_HRAW); const float* DENG = (const float*)(a->ws + WS_HSSQ); const float* EMTG = DENG + (size_t)M * 8;
    bf16* CAT = (bf16*)(a->ws + WS_CAT); const float* nw = a->in[I_MLNORM];
    f32x4 nwv[8][2];
#pragma unroll
    for (int hd = 0; hd < 8; ++hd) { const int col = hd * 512 + lane * 8; nwv[hd][0] = *(const f32x4*)(nw + col); nwv[hd][1] = *(const f32x4*)(nw + col + 4); }
    for (int t = gwave; t < M; t += GRID * NWAVES) {
        f32x4 h0[8], h1[8]; v4u zo[8]; float q[8];
#pragma unroll
        for (int hd = 0; hd < 8; ++hd) { const int col = hd * 512 + lane * 8; const v4u hw = *(const GAS v4u*)(NUM + (size_t)t * D + col); h0[hd] = (f32x4){bflo(hw[0]), bfhi(hw[0]), bflo(hw[1]), bfhi(hw[1])}; h1[hd] = (f32x4){bflo(hw[2]), bfhi(hw[2]), bflo(hw[3]), bfhi(hw[3])};
            zo[hd] = *(const GAS v4u*)(Z + (size_t)t * LDZ1 + MC_O + col); }
#pragma unroll
        for (int hd = 0; hd < 8; ++hd) { const float den = ((const GAS float*)DENG)[t * 8 + hd], emt = ((const GAS float*)EMTG)[t * 8 + hd], dinv = 1.0f / fmaxf(fabsf(den), emt);
            h0[hd] = h0[hd] * dinv; h1[hd] = h1[hd] * dinv;
            q[hd] = ((h0[hd][0] * h0[hd][0] + h0[hd][1] * h0[hd][1]) + (h0[hd][2] * h0[hd][2] + h0[hd][3] * h0[hd][3])) + ((h1[hd][0] * h1[hd][0] + h1[hd][1] * h1[hd][1]) + (h1[hd][2] * h1[hd][2] + h1[hd][3] * h1[hd][3])); }
#pragma unroll
        for (int o = 1; o < 64; o <<= 1)
#pragma unroll
            for (int hd = 0; hd < 8; ++hd) q[hd] += __shfl_xor(q[hd], o);
#pragma unroll
        for (int hd = 0; hd < 8; ++hd) { const int col = hd * 512 + lane * 8; const float rs = 1.0f / sqrtf(q[hd] * (1.f / 512.f) + NORM_EPS);
            const f32x4 n0 = nwv[hd][0], n1 = nwv[hd][1]; float o[8];
#pragma unroll
            for (int x = 0; x < 4; ++x) { o[x] = h0[hd][x] * rs * n0[x]; o[4 + x] = h1[hd][x] * rs * n1[x]; }
#pragma unroll
            for (int x = 0; x < 4; ++x) { o[2 * x] *= fsigmoid(bflo(zo[hd][x])); o[2 * x + 1] *= fsigmoid(bfhi(zo[hd][x])); }
            v4u w; w.x = pk2(o[0], o[1]); w.y = pk2(o[2], o[3]); w.z = pk2(o[4], o[5]); w.w = pk2(o[6], o[7]);
            *(GAS v4u*)(CAT + (size_t)t * D + col) = w; }
    }
}
struct LruRaw { v4u z[4][4]; v4u gz; };
__device__ __forceinline__ void lru_load(LruRaw& R, const bf16* Z, int b, int hh, int slab, int j, int tt, int c8) {
    const int tpos = j * 64 + tt; const bf16* zrow = Z + ((size_t)b * SEQ + tpos) * LDZ0 + hh * 256;
#pragma unroll
    for (int e = 0; e < 4; ++e)
#pragma unroll
        for (int d = 0; d < 4; ++d) R.z[e][d] = (tpos - d >= 0) ? *(const GAS v4u*)(zrow - (size_t)d * LDZ0 + (c8 + 8 * e) * 8) : (v4u){0u, 0u, 0u, 0u};
    R.gz = *(const GAS v4u*)(zrow + 2048 + slab * 64 + c8 * 8);
}
__device__ __forceinline__ void rglru_phase(LAS unsigned char* lds, const CAS Args* a, int w, int tid) {
    LAS bf16* UCB = (LAS bf16*)lds;
    LAS float* RI = (LAS float*)(UCB + 64 * 264);
    LAS float* UCO = RI + 8192;
    LAS float* G_ = UCO + 4096;
    LAS float* CW = G_ + 4096;
    LAS float* SEG = CW + 1280;
    LAS float* HC = SEG + 1024;
    const bf16* Z = (const bf16*)(a->ws + WS_Z); bf16* CAT = (bf16*)(a->ws + WS_CAT);
    const float* cw = a->in[I_CONVW]; const float* cb = a->in[I_CONVB];
    const float* ba = a->in[I_BA]; const float* bx = a->in[I_BX]; const float* lam = a->in[I_LAM];
    const int b = w >> 5, hh = (w >> 2) & 7, slab = w & 3, lane = tid & 63, wave = __builtin_amdgcn_readfirstlane(tid >> 6);
    const int stt = tid >> 3, sc8 = tid & 7;
    const int jch = tid & 63, sg = tid >> 6, c = hh * 256 + slab * 64 + jch;
    const int i = lane & 15, g = lane >> 4, mt = wave >> 2, ct = wave & 3;
    for (int u = tid; u < 1280; u += NTHR) CW[u] = (u < 1024) ? cw[(u >> 8) * 2048 + hh * 256 + (u & 255)] : cb[hh * 256 + (u - 1024)];
    if (tid < 128) HC[tid] = 0.f;
    const float sp = softplusf_(-lam[c]), bav = ba[c], bxv = bx[c];
    s16x8_t bw[8];
    { const bf16* wt = (const bf16*)(a->ws + (mt ? WS_WXT : WS_WAT)) + (size_t)(slab * 64 + ct * 16 + i) * 2048 + hh * 256 + 8 * g;
#pragma unroll
      for (int ks = 0; ks < 8; ++ks) bw[ks] = *(const GAS s16x8_t*)(wt + 32 * ks); }
    LruRaw R; lru_load(R, Z, b, hh, slab, 0, stt, sc8);
    LDS_WAIT(); __syncthreads();
    for (int j = 0; j < SEQ / 64; ++j) {
#pragma unroll
        for (int e = 0; e < 4; ++e) { const int ch = (sc8 + 8 * e) * 8; float acc[8];
#pragma unroll
            for (int x = 0; x < 8; x += 4) { const f32x4 bb = *(const LAS f32x4*)(CW + 1024 + ch + x); acc[x] = bb[0]; acc[x + 1] = bb[1]; acc[x + 2] = bb[2]; acc[x + 3] = bb[3]; }
#pragma unroll
            for (int d = 0; d < 4; ++d) { const f32x4 w0 = *(const LAS f32x4*)(CW + (3 - d) * 256 + ch), w1 = *(const LAS f32x4*)(CW + (3 - d) * 256 + ch + 4); const v4u zz = R.z[e][d];
                acc[0] += w0[0] * bflo(zz[0]); acc[1] += w0[1] * bfhi(zz[0]); acc[2] += w0[2] * bflo(zz[1]); acc[3] += w0[3] * bfhi(zz[1]);
                acc[4] += w1[0] * bflo(zz[2]); acc[5] += w1[1] * bfhi(zz[2]); acc[6] += w1[2] * bflo(zz[3]); acc[7] += w1[3] * bfhi(zz[3]); }
            v4u o; o.x = pk2(acc[0], acc[1]); o.y = pk2(acc[2], acc[3]); o.z = pk2(acc[4], acc[5]); o.w = pk2(acc[6], acc[7]);
            *(LAS v4u*)(UCB + stt * 264 + ch) = o;
            if ((sc8 + 8 * e) >> 3 == slab) { LAS float* uo = UCO + stt * 64 + (ch - slab * 64); *(LAS f32x4*)uo = (f32x4){acc[0], acc[1], acc[2], acc[3]}; *(LAS f32x4*)(uo + 4) = (f32x4){acc[4], acc[5], acc[6], acc[7]}; } }
        { LAS float* gp = G_ + stt * 64 + sc8 * 8; const v4u zz = R.gz;
          *(LAS f32x4*)gp = (f32x4){fgelu_tanh(bflo(zz[0])), fgelu_tanh(bfhi(zz[0])), fgelu_tanh(bflo(zz[1])), fgelu_tanh(bfhi(zz[1]))};
          *(LAS f32x4*)(gp + 4) = (f32x4){fgelu_tanh(bflo(zz[2])), fgelu_tanh(bfhi(zz[2])), fgelu_tanh(bflo(zz[3])), fgelu_tanh(bfhi(zz[3]))}; }
        LDS_WAIT(); __syncthreads();
        if (j + 1 < SEQ / 64) lru_load(R, Z, b, hh, slab, j + 1, stt, sc8);
        { f32x4 acc[4];
#pragma unroll
          for (int t4 = 0; t4 < 4; ++t4) acc[t4] = (f32x4){0.f, 0.f, 0.f, 0.f};
#pragma unroll
          for (int ks = 0; ks < 8; ++ks)
#pragma unroll
              for (int t4 = 0; t4 < 4; ++t4) acc[t4] = MFMA16(*(const LAS s16x8_t*)(UCB + (16 * t4 + i) * 264 + 32 * ks + 8 * g), bw[ks], acc[t4]);
#pragma unroll
          for (int t4 = 0; t4 < 4; ++t4)
#pragma unroll
              for (int r = 0; r < 4; ++r) RI[mt * 4096 + (16 * t4 + 4 * g + r) * 64 + ct * 16 + i] = acc[t4][r]; }
        LDS_WAIT(); __syncthreads();
        float av[8], bv[8]; float pp = 1.f, hl = 0.f;
#pragma unroll
        for (int t8 = 0; t8 < 8; ++t8) { const int tt = sg * 8 + t8;
            const float rg = fsigmoid(RI[tt * 64 + jch] + bav), ig = fsigmoid(RI[4096 + tt * 64 + jch] + bxv), la = -8.0f * rg * sp;
            av[t8] = fexp(la); bv[t8] = __builtin_amdgcn_sqrtf(fmaxf(__builtin_fmaf(-av[t8], av[t8], 1.f), 0.f)) * (ig * UCO[tt * 64 + jch]);
            pp *= av[t8]; hl = av[t8] * hl + bv[t8]; }
        SEG[(sg * 64 + jch) * 2] = pp; SEG[(sg * 64 + jch) * 2 + 1] = hl;
        LDS_WAIT(); __syncthreads();
        { float hc = HC[(j & 1) * 64 + jch];
          for (int s2 = 0; s2 < sg; ++s2) hc = SEG[(s2 * 64 + jch) * 2] * hc + SEG[(s2 * 64 + jch) * 2 + 1];
#pragma unroll
          for (int t8 = 0; t8 < 8; ++t8) { const int tt = sg * 8 + t8; hc = av[t8] * hc + bv[t8]; RI[tt * 64 + jch] = hc * G_[tt * 64 + jch]; }
          if (sg == 7) HC[((j + 1) & 1) * 64 + jch] = hc; }
        LDS_WAIT(); __syncthreads();
        { const int tt = tid >> 3, c8 = (tid & 7) * 8; const f32x4 p = *(const LAS f32x4*)(RI + tt * 64 + c8), q = *(const LAS f32x4*)(RI + tt * 64 + c8 + 4);
          v4u o; o.x = pk2(p[0], p[1]); o.y = pk2(p[2], p[3]); o.z = pk2(q[0], q[1]); o.w = pk2(q[2], q[3]);
          *(GAS v4u*)(CAT + ((size_t)b * SEQ + j * 64 + tt) * D + hh * 256 + slab * 64 + c8) = o; }
        LDS_WAIT(); __syncthreads();
    }
}
__device__ __forceinline__ void final_norm(const CAS Args* a, int vcu, int wave, int lane) {
    const float* gw_ = a->in[I_NFIN]; const bf16* XB = (const bf16*)(a->ws + WS_XB); const int gw = vcu * NWAVES + wave, NGW = GRID * NWAVES;
    f32x4 gn[8][2];
#pragma unroll
    for (int j = 0; j < 8; ++j) { const int c8 = (lane + 64 * j) * 8; gn[j][0] = *(const f32x4*)(gw_ + c8); gn[j][1] = *(const f32x4*)(gw_ + c8 + 4); }
    for (int m = gw; m < M; m += NGW) {
        const GAS v4u* xr = (const GAS v4u*)(XB + (size_t)m * D) + lane; v4u v[8]; float s = 0.f;
#pragma unroll
        for (int j = 0; j < 8; ++j) { v[j] = xr[64 * j];
#pragma unroll
            for (int x = 0; x < 4; ++x) { const float lo = bflo(v[j][x]), hi = bfhi(v[j][x]); s += lo * lo + hi * hi; } }
        const float rstd = 1.0f / sqrtf(wave_sum(s) * (1.0f / D) + NORM_EPS);
        GAS f32x4* orow = (GAS f32x4*)(a->out + (size_t)m * D);
#pragma unroll
        for (int j = 0; j < 8; ++j) { const int c8 = (lane + 64 * j) * 8; const f32x4 g0 = gn[j][0], g1 = gn[j][1];
            orow[c8 / 4] = (f32x4){bflo(v[j][0]) * rstd * g0[0], bfhi(v[j][0]) * rstd * g0[1], bflo(v[j][1]) * rstd * g0[2], bfhi(v[j][1]) * rstd * g0[3]};
            orow[c8 / 4 + 1] = (f32x4){bflo(v[j][2]) * rstd * g1[0], bfhi(v[j][2]) * rstd * g1[1], bflo(v[j][3]) * rstd * g1[2], bfhi(v[j][3]) * rstd * g1[3]}; }
    }
}

__device__ __forceinline__ const CAS Args* fresh_args() { const CAS Args* p = (const CAS Args*)__builtin_amdgcn_kernarg_segment_ptr(); asm volatile("" : "+s"(p)); return p; }
__device__ __forceinline__ bool in_phase(int k) { const CAS Args* p = fresh_args(); return p->ph_lo <= k && k < p->ph_hi; }
__device__ __forceinline__ int fresh_tid() { int t = threadIdx.x; asm volatile("" : "+v"(t)); return t; }
__device__ __forceinline__ int vcu_of() { const int bx = blockIdx.x; return (bx % 8) * (GRID / 8) + bx / 8; }
__device__ __forceinline__ void seam(LAS unsigned char* lds, int k) {
    if (MK_N_LAUNCHES != 1) return;
    if (in_phase(k) && in_phase(k + 1)) { const CAS Args* a = fresh_args(); XcdBarrier bar; bar.bar = (unsigned*)(a->ws + WS_CTL) + CW_BAR; bar.x = xb_xcc_id(); bar.st = (volatile LAS unsigned*)(lds + MISC_OFF) + 8; xcd_barrier(bar); }
}
template <int L> __device__ __forceinline__ void layer_phases(LAS unsigned char* lds) {
    constexpr int p_in = 1 + 7 * L, p_out = 5 + 6 * L, p_up = 6 + 6 * L, p_down = 7 + 6 * L;
    if (in_phase(p_in)) {
        const CAS Args* a = fresh_args(); unsigned char* ws = a->ws; const int tid = fresh_tid(); constexpr int ldz = L ? LDZ1 : LDZ0;
        pg8::Gemm g{(const bf16*)(ws + WS_XB), (const bf16*)(ws + (L ? WS_WMLIN : WS_WHYIN)), D, D, D};
        LAS float* rstab = (LAS float*)(lds + RS_OFF);
        if (L == 1) {
          constexpr int nmain = 12288;
          pg8::StaticOrder S; S.init(M, nmain, GRID, blockIdx.x);
          build_rs(rstab, S, (const float*)(ws + WS_SSQ), 64, tid);
          pg8::EpiScale<0> E{(bf16*)(ws + WS_Z), ldz, rstab};
          pg8::gemm_phase<pg8::EpiScale<0>, pg8::StaticOrder, true, true>(lds, g, S, E);
          const CAS Args* a2 = fresh_args(); unsigned char* ws2 = a2->ws; const int tid2 = fresh_tid();
          constexpr int SK = 8, KC = D / SK, NREM = 16;
          pg8::Gemm g2{(const bf16*)(ws2 + WS_XB), (const bf16*)(ws2 + WS_WMLIN) + (size_t)nmain * D, D, D, KC};
          pg8::SplitOrder S2; S2.init(M / 256, 1, SK, KC, GRID, blockIdx.x);
          build_rs(rstab, S2, (const float*)(ws2 + WS_SSQ), 64, tid2);
          pg8::EpiPartial E2{(float*)(ws2 + WS_ZP), NREM, NREM, M, rstab};
          pg8::gemm_phase<pg8::EpiPartial, pg8::SplitOrder, true, true>(lds, g2, S2, E2);
        } else if (blockIdx.x < G1_WGS) {
          pg8::StaticOrder S; S.init(M, LDZ0, G1_WGS, blockIdx.x);
          build_rs(rstab, S, (const float*)(ws + WS_SSQ), 1, tid);
          pg8::EpiScale<0> E{(bf16*)(ws + WS_Z), ldz, rstab};
          pg8::gemm_phase<pg8::EpiScale<0>, pg8::StaticOrder, true, true>(lds, g, S, E);
        } else {
          const int t2 = fresh_tid(); const int wv = __builtin_amdgcn_readfirstlane(t2 >> 6);
          conv_range(lds, fresh_args(), CONV_A0, CONV_A, (blockIdx.x - G1_WGS) * NWAVES + wv, (GRID - G1_WGS) * NWAVES, wv, t2 & 63);
        }
    }
    seam(lds, p_in);
    if (L == 0) {
        if (in_phase(2)) rwkv_prepass(fresh_args(), vcu_of() * NTHR + fresh_tid());
        seam(lds, 2);
        if (in_phase(3)) {
            for (int q = 0; q < 3; ++q) {
                const CAS Args* a = fresh_args(); unsigned char* ws = a->ws;
                const int kq = (q == 2) ? 256 : 128;
                pg8::Gemm g{(const bf16*)(ws + (q == 0 ? WS_AW : (q == 1 ? WS_AAL : WS_AG))), (const bf16*)(ws + (q == 0 ? WS_W2T : (q == 1 ? WS_A2T : WS_G2T))), kq, kq, kq};
                pg8::StaticOrder S; S.init(M, 2048, GRID, blockIdx.x);
                pg8::EpiLora E{(bf16*)(ws + (q == 0 ? WS_DEC : (q == 1 ? WS_AA : WS_GG))), 2048, q == 0 ? a->in[I_W0] : a->in[I_A0], q};
                pg8::gemm_phase<pg8::EpiLora, pg8::StaticOrder, true, true>(lds, g, S, E);
            }
        }
        seam(lds, 3);
        if (in_phase(4)) { const int vcu = vcu_of(); if (vcu < 128) rwkv_phase(lds, fresh_args(), vcu, fresh_tid()); else rglru_phase(lds, fresh_args(), vcu - 128, fresh_tid());
            conv_queue(lds, fresh_args(), CONV_A, CONV_B, 0, fresh_tid()); }
        seam(lds, 4);
    } else {
        if (in_phase(9)) { const int vcu = vcu_of(); if (vcu < 128) mlstm_num_phase(lds, fresh_args(), vcu, fresh_tid()); else if (vcu < 160) mlstm_den_phase(lds, fresh_args(), vcu - 128, fresh_tid());
            conv_queue(lds, fresh_args(), CONV_B, CONV_TOTAL, 1, fresh_tid()); }
        seam(lds, 9);
        if (in_phase(10)) { const int tid = fresh_tid(); mlstm_post(fresh_args(), vcu_of() * NWAVES + __builtin_amdgcn_readfirstlane(tid >> 6), tid & 63); }
        seam(lds, 10);
    }
    if (in_phase(p_out)) {
        const CAS Args* a = fresh_args(); unsigned char* ws = a->ws;
        pg8::Gemm g{(const bf16*)(ws + WS_CAT), (const bf16*)(ws + (L ? WS_WMLOUT : WS_WHYOUT)), D, D, D};
        pg8::StaticOrder S; S.init(M, D, GRID, blockIdx.x);
        pg8::EpiResid<false> E{(const bf16*)(ws + WS_XB), (bf16*)(ws + WS_XB), (float*)nullptr, (float*)(ws + WS_SSQ), D};
        pg8::gemm_phase<pg8::EpiResid<false>, pg8::StaticOrder, true, true>(lds, g, S, E);
    }
    seam(lds, p_out);
    if (in_phase(p_up)) {
        const CAS Args* a = fresh_args(); unsigned char* ws = a->ws; const int tid = fresh_tid();
        pg8::Gemm g{(const bf16*)(ws + WS_XB), (const bf16*)(ws + WS_WUP + (size_t)L * FF * D * 2), D, D, D};
        pg8::StaticOrder S; S.init(M, FF, GRID, blockIdx.x);
        LAS float* rstab = (LAS float*)(lds + RS_OFF);
        build_rs(rstab, S, (const float*)(ws + WS_SSQ), 64, tid);
        pg8::EpiScale<1> E{(bf16*)(ws + WS_U), FF, rstab};
        pg8::gemm_phase<pg8::EpiScale<1>, pg8::StaticOrder, true, true>(lds, g, S, E);
    }
    seam(lds, p_up);
    if (in_phase(p_down)) {
        const CAS Args* a = fresh_args(); unsigned char* ws = a->ws;
        pg8::Gemm g{(const bf16*)(ws + WS_U), (const bf16*)(ws + WS_WDOWN + (size_t)L * FF * D * 2), FF, FF, FF};
        pg8::StaticOrder S; S.init(M, D, GRID, blockIdx.x);
        pg8::EpiResid<false> E{(const bf16*)(ws + WS_XB), (bf16*)(ws + WS_XB), (float*)nullptr, (float*)(ws + WS_SSQ), D};
        pg8::gemm_phase<pg8::EpiResid<false>, pg8::StaticOrder, true, true>(lds, g, S, E);
    }
    seam(lds, p_down);
}
__global__ void __launch_bounds__(NTHR, 2) fwd_kernel(Args args) {
    extern __shared__ __attribute__((aligned(16))) unsigned char lds_raw[];
    LAS unsigned char* lds = (LAS unsigned char*)lds_raw;
    { const int tid = threadIdx.x;
      for (int u = tid; u < (LDS_BYTES - LDSCTL_OFF) / 4; u += NTHR) ((LAS unsigned*)(lds + LDSCTL_OFF))[u] = 0u;
      __syncthreads();
      if (MK_N_LAUNCHES == 1) { const CAS Args* a = fresh_args(); (void)xcd_barrier_post((unsigned*)(a->ws + WS_CTL) + CW_BAR, (volatile LAS unsigned*)(lds + MISC_OFF) + 8); } }
    if (in_phase(0)) { const int tid = fresh_tid(); p0_prologue(lds, fresh_args(), vcu_of(), __builtin_amdgcn_readfirstlane(tid >> 6), tid & 63); }
    seam(lds, 0);
    layer_phases<0>(lds);
    layer_phases<1>(lds);
    if (in_phase(14)) { const int tid = fresh_tid(); final_norm(fresh_args(), vcu_of(), __builtin_amdgcn_readfirstlane(tid >> 6), tid & 63); }
}

extern "C" void kernel_launch(void* const* d_in, const int* in_sizes, int n_in, void* d_out, int out_size, void* d_ws, size_t ws_size, hipStream_t stream) {
    static int ready = 0;
    if (ready == 0) {
        if (n_in != 31 || out_size != M * D || ws_size < WS_END) { fprintf(stderr, "kernel_launch: unexpected shapes (n_in %d, out %d, ws %zu < %zu); nothing launched\n", n_in, out_size, ws_size, (size_t)WS_END); ready = -1; return; }
        if (hipFuncSetAttribute((const void*)fwd_kernel, hipFuncAttributeMaxDynamicSharedMemorySize, LDS_BYTES) != hipSuccess) { fprintf(stderr, "kernel_launch: hipFuncSetAttribute failed\n"); ready = -1; return; }
        int per_cu = 0;
        if (hipOccupancyMaxActiveBlocksPerMultiprocessor(&per_cu, (const void*)fwd_kernel, NTHR, LDS_BYTES) != hipSuccess || per_cu < 1)
            fprintf(stderr, "kernel_launch: note: occupancy query reports %d workgroups per CU\n", per_cu);
        (void)hipGetLastError();
        ready = 1;
    }
    if (ready < 0) return;
    if (hipMemsetAsync((char*)d_ws + WS_CTL, 0, CTL_ZERO_BYTES, stream) != hipSuccess) { fprintf(stderr, "kernel_launch: memset failed\n"); return; }
    Args a{};
    for (int i = 0; i < 31; ++i) a.in[i] = (const float*)d_in[i];
    a.out = (float*)d_out; a.ws = (unsigned char*)d_ws;
    if (MK_N_LAUNCHES == 1) { a.ph_lo = 0; a.ph_hi = N_PHASES; hipLaunchKernelGGL(fwd_kernel, dim3(GRID), dim3(NTHR), LDS_BYTES, stream, a); }
    else { for (int p = 0; p < N_PHASES; ++p) { a.ph_lo = p; a.ph_hi = p + 1; hipLaunchKernelGGL(fwd_kernel, dim3(GRID), dim3(NTHR), LDS_BYTES, stream, a); } }
    const hipError_t le = hipPeekAtLastError();
    if (le != hipSuccess) fprintf(stderr, "kernel_launch: launch failed: %s\n", hipGetErrorName(le));
}
```
